# Optimizing an MI355X kernel written in HIP

```python
import math
import jax, jax.numpy as jnp
from jax import lax
import numpy as np

D_MODEL = 1024
BATCH = 4
SEQ = 4096
DEPTH = 2

CHUNK = 64
QBLOCK = 128
EPS = 1e-6
ADA_STD = 0.2

D_FF = 4 * D_MODEL

MIX_A = D_MODEL // 2
POOL_WINDOWS = (2, 4, 8, 16)
POOL_GROUPS = len(POOL_WINDOWS)
POOL_CH = MIX_A // POOL_GROUPS
MIX_B = D_MODEL - MIX_A
SSM_GROUP = 16
SSM_GROUPS = MIX_B // SSM_GROUP
SSM_STATE = 64
DT_MIN = 1e-3
DT_MAX = 1e-1

HEAD_DIM = 64
C_HEADS = (D_MODEL // 2) // HEAD_DIM
D_HEADS = (D_MODEL // 2) // HEAD_DIM
C_W = C_HEADS * HEAD_DIM
D_W = D_HEADS * HEAD_DIM
IDX_HEADS = 8
IDX_DIM = 64
IDX_SCALE = (IDX_HEADS ** -0.5) * (IDX_DIM ** -0.5)
TOPK_MAX = 256
IN_CD_WIDTHS = (C_W, C_W, C_W, IDX_HEADS * IDX_DIM, IDX_DIM, IDX_HEADS, D_W, D_W, D_W)
IN_CD = sum(IN_CD_WIDTHS)

N_EVEN = (DEPTH + 1) // 2
N_ODD = DEPTH // 2

kernel_name = "hybrid_pool_s5_dsa_stickbreak_trunk"


def _rmsnorm(x, g):
    xf = x.astype(jnp.float32)
    y = xf * lax.rsqrt(jnp.mean(xf * xf, axis=-1, keepdims=True) + EPS)
    return (y * g.astype(jnp.float32)).astype(x.dtype)


def _modulate(x, c, g, w, b):
    m = (c @ w + b)[:, None, :]
    shift, scale, gate = jnp.split(m, 3, axis=-1)
    h = _rmsnorm(x, g) * (1.0 + scale) + shift
    return h, 1.0 + gate


def _to_blocks(a):
    b, l = a.shape[:2]
    return jnp.moveaxis(a.reshape(b, l // QBLOCK, QBLOCK, *a.shape[2:]), 1, 0)


def _from_blocks(a):
    a = jnp.moveaxis(a, 0, 1)
    return a.reshape(a.shape[0], a.shape[1] * a.shape[2], -1)


def _pool_mixer(u, w_pool, scale):
    bsz, L, _ = u.shape
    ug = u.astype(jnp.float32).reshape(bsz, L, POOL_GROUPS, POOL_CH)
    cs = jnp.concatenate([jnp.zeros((bsz, 1, POOL_GROUPS, POOL_CH), jnp.float32),
                          jnp.cumsum(ug, axis=1)], axis=1)
    t = jnp.arange(L)
    pooled = []
    for g, win in enumerate(POOL_WINDOWS):
        lo = jnp.maximum(t + 1 - win, 0)
        cnt = jnp.minimum(t + 1, win).astype(jnp.float32)
        pooled.append((cs[:, 1:, g] - cs[:, lo, g]) / cnt[None, :, None])
    p = jnp.stack(pooled, axis=2) - ug
    y = jnp.einsum('blgc,gcd->blgd', p, w_pool.astype(jnp.float32))
    return (y.reshape(bsz, L, MIX_A) * scale.astype(jnp.float32)).astype(u.dtype)


def _ssm_combine(e1, e2):
    a1r, a1i, b1r, b1i = e1
    a2r, a2i, b2r, b2i = e2
    return (a2r * a1r - a2i * a1i,
            a2r * a1i + a2i * a1r,
            a2r * b1r - a2i * b1i + b2r,
            a2r * b1i + a2i * b1r + b2i)


def _s5_mixer(u, lam_re, lam_im, log_dt, b_re, b_im, c_re, c_im, d_skip, w_glu, b_glu):
    bsz, L, _ = u.shape
    f32 = jnp.float32
    ug = u.astype(f32).reshape(bsz, L, SSM_GROUPS, SSM_GROUP)
    lr, li = lam_re.astype(f32), lam_im.astype(f32)
    dt = jnp.exp(log_dt.astype(f32))[:, None]
    mag = jnp.exp(lr * dt)
    ar, ai = mag * jnp.cos(li * dt), mag * jnp.sin(li * dt)
    den = lr * lr + li * li
    zr = ((ar - 1.0) * lr + ai * li) / den
    zi = (ai * lr - (ar - 1.0) * li) / den
    br, bi = b_re.astype(f32), b_im.astype(f32)
    bbr = zr[..., None] * br - zi[..., None] * bi
    bbi = zr[..., None] * bi + zi[..., None] * br
    xr = jnp.einsum('blgc,gpc->blgp', ug, bbr)
    xi = jnp.einsum('blgc,gpc->blgp', ug, bbi)
    a_r = jnp.broadcast_to(ar, (1, L, SSM_GROUPS, SSM_STATE))
    a_i = jnp.broadcast_to(ai, (1, L, SSM_GROUPS, SSM_STATE))
    _, _, hr, hi = lax.associative_scan(_ssm_combine, (a_r, a_i, xr, xi), axis=1)
    y = (jnp.einsum('gcp,blgp->blgc', c_re.astype(f32), hr)
         - jnp.einsum('gcp,blgp->blgc', c_im.astype(f32), hi)
         + d_skip.astype(f32).reshape(SSM_GROUPS, SSM_GROUP) * ug)
    y = jax.nn.gelu(y.reshape(bsz, L, MIX_B))
    y = y * jax.nn.sigmoid(y @ w_glu.astype(f32) + b_glu.astype(f32))
    return y.astype(u.dtype)


def _alibi_slopes(n_heads):
    return jnp.exp2(-8.0 * jnp.arange(1, n_heads + 1, dtype=jnp.float32) / n_heads)


def _dsa_mixer(q, k, v, qi, ki, wi):
    L = q.shape[1]
    topk = min(TOPK_MAX, L // 4)
    key_chunk = jnp.arange(L) // CHUNK
    slopes = _alibi_slopes(C_HEADS)
    nb = L // QBLOCK

    def step(args):
        qb, qib, wib, t0 = args
        t = t0 + jnp.arange(QBLOCK)
        q_chunk = t // CHUNK
        adm = key_chunk[None, :] <= q_chunk[:, None]
        rel = jax.nn.relu(jnp.einsum('bqhd,bsd->bqhs', qib, ki))
        score = jnp.einsum('bqhs,bqh->bqs', rel, wib) * IDX_SCALE
        score = jnp.where(adm[None], score, -jnp.inf)
        _, sel = lax.top_k(score, topk)
        valid = (sel // CHUNK) <= q_chunk[None, :, None]
        kg = jax.vmap(lambda kb, ib: kb[ib])(k, sel)
        vg = jax.vmap(lambda vb, ib: vb[ib])(v, sel)
        logits = jnp.einsum('bqhd,bqkhd->bhqk', qb, kg) * (HEAD_DIM ** -0.5)
        dist = jnp.abs(t[None, :, None] - sel).astype(jnp.float32)
        logits = logits - slopes[None, :, None, None] * dist[:, None]
        logits = jnp.where(valid[:, None], logits, -jnp.inf)
        p = jax.nn.softmax(logits, axis=-1)
        return jnp.einsum('bhqk,bqkhd->bqhd', p, vg)

    out = lax.map(step, (_to_blocks(q), _to_blocks(qi), _to_blocks(wi),
                         jnp.arange(nb, dtype=jnp.int32) * QBLOCK))
    return _from_blocks(out)


def _stick_breaking_mixer(q, k, v):
    L = q.shape[1]
    pos = jnp.arange(L)
    nb = L // QBLOCK

    def step(args):
        qb, t0 = args
        t = t0 + jnp.arange(QBLOCK)
        z = jnp.einsum('bqhd,bshd->bhqs', qb, k) * (HEAD_DIM ** -0.5)
        causal = (pos[None, :] < t[:, None])[None, None]
        log_keep = jnp.where(causal, jax.nn.log_sigmoid(-z), 0.0)
        after = lax.cumsum(log_keep, axis=3, reverse=True) - log_keep
        w = jnp.where(causal, jnp.exp(jax.nn.log_sigmoid(z) + after), 0.0)
        return jnp.einsum('bhqs,bshd->bqhd', w, v)

    out = lax.map(step, (_to_blocks(q), jnp.arange(nb, dtype=jnp.int32) * QBLOCK))
    return _from_blocks(out)


def _ab_mixer(h, w_in, w_out, pool_w, pool_scale, lam_re, lam_im, log_dt,
              b_re, b_im, c_re, c_im, d_skip, w_glu, b_glu):
    proj = h @ w_in
    ua, ub = proj[..., :MIX_A], proj[..., MIX_A:]
    ya = _pool_mixer(ua, pool_w, pool_scale)
    yb = _s5_mixer(ub, lam_re, lam_im, log_dt, b_re, b_im, c_re, c_im, d_skip, w_glu, b_glu)
    return jnp.concatenate([ya, yb], axis=-1) @ w_out


def _cd_mixer(h, w_in, w_out):
    bsz, L, _ = h.shape
    f32 = jnp.float32
    proj = (h @ w_in).astype(f32)
    offs = np.cumsum(IN_CD_WIDTHS)[:-1].tolist()
    qc, kc, vc, qi, ki, wi, qd, kd, vd = jnp.split(proj, offs, axis=-1)
    hd = lambda a, n: a.reshape(bsz, L, n, -1)
    oc = _dsa_mixer(hd(qc, C_HEADS), hd(kc, C_HEADS), hd(vc, C_HEADS),
                    hd(qi, IDX_HEADS), ki, wi)
    od = _stick_breaking_mixer(hd(qd, D_HEADS), hd(kd, D_HEADS), hd(vd, D_HEADS))
    y = jnp.concatenate([oc, od], axis=-1).astype(h.dtype)
    return y @ w_out


def _sq_relu_mlp(h, w1, w2):
    a = jax.nn.relu(h @ w1)
    return (a * a) @ w2


def setup_inputs(seed: int = 0) -> dict:
    key = jax.random.key(seed)
    ks = jax.random.split(key, 26)
    f32 = jnp.float32
    nrm = lambda k, shape, s: jax.random.normal(k, shape, f32) * s
    D = D_MODEL
    G, P, C = SSM_GROUPS, SSM_STATE, SSM_GROUP
    return {
        "x": nrm(ks[0], (BATCH, SEQ, D), 1.0),
        "c": nrm(ks[1], (BATCH, D), 1.0),
        "norm_g": 1.0 + nrm(ks[2], (DEPTH, 2, D), 0.1),
        "ada_w": nrm(ks[3], (DEPTH, 2, D, 3 * D), ADA_STD * D ** -0.5),
        "ada_b": nrm(ks[4], (DEPTH, 2, 3 * D), 0.01),
        "mlp_w1": nrm(ks[5], (DEPTH, D, D_FF), D ** -0.5),
        "mlp_w2": nrm(ks[6], (DEPTH, D_FF, D), D_FF ** -0.5),
        "ab_w_in": nrm(ks[7], (N_EVEN, D, MIX_A + MIX_B), D ** -0.5),
        "ab_w_out": nrm(ks[8], (N_EVEN, MIX_A + MIX_B, D), (MIX_A + MIX_B) ** -0.5),
        "pool_w": nrm(ks[9], (N_EVEN, POOL_GROUPS, POOL_CH, POOL_CH), POOL_CH ** -0.5),
        "pool_scale": 1.0 + nrm(ks[10], (N_EVEN, MIX_A), 0.1),
        "ssm_lam_re": -0.5 + nrm(ks[11], (N_EVEN, G, P), 0.01),
        "ssm_lam_im": jnp.pi * jnp.arange(P, dtype=f32) + nrm(ks[12], (N_EVEN, G, P), 0.01),
        "ssm_log_dt": jax.random.uniform(ks[13], (N_EVEN, G), f32, math.log(DT_MIN), math.log(DT_MAX)),
        "ssm_b_re": nrm(ks[14], (N_EVEN, G, P, C), (2 * C) ** -0.5),
        "ssm_b_im": nrm(ks[15], (N_EVEN, G, P, C), (2 * C) ** -0.5),
        "ssm_c_re": nrm(ks[16], (N_EVEN, G, C, P), (2 * P) ** -0.5),
        "ssm_c_im": nrm(ks[17], (N_EVEN, G, C, P), (2 * P) ** -0.5),
        "ssm_d": nrm(ks[18], (N_EVEN, MIX_B), 1.0),
        "glu_w": nrm(ks[19], (N_EVEN, MIX_B, MIX_B), MIX_B ** -0.5),
        "glu_b": nrm(ks[20], (N_EVEN, MIX_B), 0.01),
        "cd_w_in": nrm(ks[21], (N_ODD, D, IN_CD), D ** -0.5),
        "cd_w_out": nrm(ks[22], (N_ODD, C_W + D_W, D), (C_W + D_W) ** -0.5),
        "final_g": 1.0 + nrm(ks[23], (D,), 0.1),
    }


def reference(x, c, norm_g, ada_w, ada_b, mlp_w1, mlp_w2, ab_w_in, ab_w_out, pool_w, pool_scale,
              ssm_lam_re, ssm_lam_im, ssm_log_dt, ssm_b_re, ssm_b_im, ssm_c_re, ssm_c_im, ssm_d,
              glu_w, glu_b, cd_w_in, cd_w_out, final_g):
    for i in range(DEPTH):
        j = i // 2
        h, gate = _modulate(x, c, norm_g[i, 0], ada_w[i, 0], ada_b[i, 0])
        if i % 2 == 0:
            y = _ab_mixer(h, ab_w_in[j], ab_w_out[j], pool_w[j], pool_scale[j],
                          ssm_lam_re[j], ssm_lam_im[j], ssm_log_dt[j], ssm_b_re[j], ssm_b_im[j],
                          ssm_c_re[j], ssm_c_im[j], ssm_d[j], glu_w[j], glu_b[j])
        else:
            y = _cd_mixer(h, cd_w_in[j], cd_w_out[j])
        x = x + gate * y
        h, gate = _modulate(x, c, norm_g[i, 1], ada_w[i, 1], ada_b[i, 1])
        x = x + gate * _sq_relu_mlp(h, mlp_w1[i], mlp_w2[i])
    return _rmsnorm(x, final_g)
```

```cpp
#include <hip/hip_runtime.h>
#include <hip/hip_bf16.h>
#include <cstdio>
#include <cstdint>
#include <cmath>

#define LAS __attribute__((address_space(3)))
#define GAS __attribute__((address_space(1)))
typedef unsigned short bf16_t;
typedef short bf16x8 __attribute__((ext_vector_type(8)));
typedef float f32x4 __attribute__((ext_vector_type(4)));
typedef float f32x2 __attribute__((ext_vector_type(2)));
typedef float f32x16 __attribute__((ext_vector_type(16)));
typedef unsigned u32x4 __attribute__((ext_vector_type(4)));
typedef unsigned u32x2 __attribute__((ext_vector_type(2)));
typedef short s16x4 __attribute__((ext_vector_type(4)));
typedef __bf16 bf16x2_t __attribute__((ext_vector_type(2)));

constexpr int DM = 1024, NB = 4, SEQ = 4096, MTOK = NB * SEQ, FF = 4096;
constexpr int PW = 3840;
constexpr float EPS = 1e-6f;
constexpr float LOG2E = 1.4426950408889634f;
constexpr float C2 = 0.125f * LOG2E;
constexpr size_t WS_XB_LO = (size_t)240 << 20, WS_XB_HI = (size_t)9 << 20;
constexpr int PC_QC = 0, PC_QD = 512, PC_KC = 1024, PC_VC = 1536, PC_KD = 2048, PC_VD = 2560, PC_QI = 3072, PC_KI = 3584, PC_WI = 3648;

__device__ __forceinline__ unsigned cvtpk(float lo, float hi) { f32x2 v = {lo, hi}; bf16x2_t b = __builtin_convertvector(v, bf16x2_t); return __builtin_bit_cast(unsigned, b); }
__device__ __forceinline__ float bf2f(unsigned short h) { return __uint_as_float((unsigned)h << 16); }
__device__ __forceinline__ u32x4 pack8(const f32x4& a, const f32x4& b) { u32x4 w; w.x = cvtpk(a[0], a[1]); w.y = cvtpk(a[2], a[3]); w.z = cvtpk(b[0], b[1]); w.w = cvtpk(b[2], b[3]); return w; }

__device__ __forceinline__ void unpack8(const u32x4& w, f32x4& a, f32x4& b) {
    a = (f32x4){__uint_as_float(w.x << 16), __uint_as_float(w.x & 0xffff0000u), __uint_as_float(w.y << 16), __uint_as_float(w.y & 0xffff0000u)};
    b = (f32x4){__uint_as_float(w.z << 16), __uint_as_float(w.z & 0xffff0000u), __uint_as_float(w.w << 16), __uint_as_float(w.w & 0xffff0000u)};
}
namespace pg8 {
constexpr int BM = 256, BK = 64, HALF = 128, HTB = HALF * BK * 2, STAGE_BYTES = 8 * HTB, NXCD = 8, WGM = 8;
__host__ __device__ __forceinline__ int lds_byte(int r, int c) { const int st = (r >> 4) * 2 + (c >> 5), rr = r & 15, cc = c & 31, ob = rr * 64 + cc * 2; return st * 1024 + (ob ^ (((ob >> 9) & 1) << 5)); }
__host__ __device__ __forceinline__ void stage_rc(int b, int& R, int& C) { const int st = b / 1024, sb = b % 1024, swz = sb ^ (((sb >> 9) & 1) << 5); R = (st >> 1) * 16 + swz / 64; C = (st & 1) * 32 + (swz % 64) / 2; }
__host__ __device__ __forceinline__ int perm32(int rho) { const int n = rho >> 4, i = rho & 15; return 8 * (i >> 2) + 4 * n + (i & 3); }

struct Unit { int pm, pn, am, bn, ak; };
struct Gemm { const bf16_t* A; const bf16_t* Bt; int lda, ldb, K; };

enum { SM_STD = 0, SM_POOL = 1, SM_S5S = 2, SM_S5Y = 3 };
template <int MODE> struct Sched {
    int nM, nN, nwg, G, c;
    __device__ __forceinline__ void init(int nM_, int nN_, int G_, int c_) { nM = nM_; nN = nN_; nwg = nM_ * nN_; G = G_; c = c_; }
    __device__ __forceinline__ bool next(int i, Unit& u) const {
        if (c >= G) return false;
        const long L = (long)i * G + c; if (L >= nwg) return false;
        int pm, pn;
        if (MODE == SM_STD) {
            int wgid = (int)L; { const int q = nwg / NXCD, r = nwg % NXCD, xcd = wgid % NXCD, off = wgid / NXCD; wgid = (xcd < r ? xcd * (q + 1) : r * (q + 1) + (xcd - r) * q) + off; }
            const int nig = WGM * nN, gid = wgid / nig, fm = gid * WGM, gsz = (nM - fm) < WGM ? (nM - fm) : WGM;
            pm = fm + ((wgid % nig) % gsz); pn = (wgid % nig) / gsz;
        } else { pm = (int)L / nN; pn = (int)L % nN; }
        u.pm = pm; u.pn = pn; u.am = pm; u.bn = pn; u.ak = 0;
        if (MODE == SM_POOL) u.ak = 256 * pn;
        if (MODE == SM_S5S) u.bn = pm >> 1;
        if (MODE == SM_S5Y) u.bn = (pm >> 1) * 2 + pn;
        return true;
    }
};

template <class Epi, class SchedT, bool ALIGN_EPI>
__device__ __forceinline__ void gemm_phase(LAS unsigned char* lds, const Gemm g, const SchedT& S, const Epi& E) {
    int tid = threadIdx.x; asm volatile("" : "+v"(tid));
    const int wid = __builtin_amdgcn_readfirstlane(tid >> 6), lane = tid & 63, wr = wid >> 2, wc = wid & 3, fr = lane & 15, fq = lane >> 4;
    int K = g.K; asm volatile("" : "+s"(K));
    const int nt = K / BK;
    unsigned voffA[2], voffB[2];
#pragma unroll
    for (int i = 0; i < 2; ++i) { int R, C; stage_rc(tid * 16 + i * 8192, R, C); const int Rb = Epi::PERM ? ((R & ~31) + perm32(R & 31)) : R;
        voffA[i] = (unsigned)(R * g.lda + C) * 2u; voffB[i] = (unsigned)(Rb * g.ldb + C) * 2u; }
    const size_t kstep = (size_t)(BK * 2);
    const size_t hstepA = (size_t)HALF * g.lda * 2, hstepB = (size_t)HALF * g.ldb * 2;
    const unsigned ldsw = (unsigned)wid * 1024u;
    const int aoff = lds_byte(wr * 64 + fr, fq * 8), boff = lds_byte(wc * 32 + fr, fq * 8);
#define PG8_SA(b, h) (((b) * 2 + (h)) * HTB)
#define PG8_SB(b, h) ((4 + (b) * 2 + (h)) * HTB)
#define PG8_STAGE(bufoff, gbase, voff) do { _Pragma("unroll") for (int _i = 0; _i < 2; ++_i) \
        __builtin_amdgcn_global_load_lds((const unsigned*)((const char*)(gbase) + (voff)[_i]), (LAS unsigned*)(lds + (bufoff) + ldsw + _i * 8192), 16, 0, 0); } while (0)
#define PG8_LDA(dst, b, h) do { _Pragma("unroll") for (int m = 0; m < 4; ++m) _Pragma("unroll") for (int k = 0; k < 2; ++k) dst[m][k] = *(const LAS bf16x8*)(lds + PG8_SA(b, h) + aoff + m * 2048 + k * 1024); } while (0)
#define PG8_LDB(dst, b, h) do { _Pragma("unroll") for (int n = 0; n < 2; ++n) _Pragma("unroll") for (int k = 0; k < 2; ++k) dst[n][k] = *(const LAS bf16x8*)(lds + PG8_SB(b, h) + boff + n * 2048 + k * 1024); } while (0)
#define PG8_MMA(ai, bj, At, Bt) do { __builtin_amdgcn_s_setprio(1); _Pragma("unroll") for (int m = 0; m < 4; ++m) _Pragma("unroll") for (int n = 0; n < 2; ++n) _Pragma("unroll") for (int k = 0; k < 2; ++k) \
        acc[ai][bj][m][n] = __builtin_amdgcn_mfma_f32_16x16x32_bf16(Bt[n][k], At[m][k], acc[ai][bj][m][n], 0, 0, 0); __builtin_amdgcn_s_setprio(0); } while (0)
#define PG8_WAIT_V(n) asm volatile("s_waitcnt vmcnt(" #n ")" ::: "memory")
#define PG8_WAIT_L(n) asm volatile("s_waitcnt lgkmcnt(" #n ")" ::: "memory")
#define PG8_BAR __builtin_amdgcn_s_barrier()
#define PG8_SCHED __builtin_amdgcn_sched_barrier(0)
#define PG8_ABASE(u) ((const char*)g.A + ((size_t)(u).am * 256 * g.lda + (size_t)(u).ak) * 2)
#define PG8_BBASE(u) ((const char*)g.Bt + ((size_t)(u).bn * 256 * g.ldb) * 2)
    Unit cur, nxt; int ui = 0;
    if (!S.next(0, cur)) return;
    f32x4 acc[2][2][4][2];
#pragma unroll
    for (int a = 0; a < 2; ++a)
#pragma unroll
        for (int b = 0; b < 2; ++b)
#pragma unroll
            for (int m = 0; m < 4; ++m)
#pragma unroll
                for (int n = 0; n < 2; ++n) acc[a][b][m][n] = (f32x4){0.f, 0.f, 0.f, 0.f};
    bf16x8 At[4][2], B0[2][2], B1[2][2];
    const char* cA = PG8_ABASE(cur); const char* cB = PG8_BBASE(cur);
    PG8_STAGE(PG8_SB(0, 0), cB, voffB); PG8_STAGE(PG8_SB(0, 1), cB + hstepB, voffB); PG8_STAGE(PG8_SA(0, 0), cA, voffA); PG8_STAGE(PG8_SA(0, 1), cA + hstepA, voffA);
    if (wr == 1) PG8_BAR;
    PG8_WAIT_V(2); PG8_BAR;
    PG8_STAGE(PG8_SB(1, 0), cB + kstep, voffB); PG8_STAGE(PG8_SA(1, 0), cA + kstep, voffA); PG8_STAGE(PG8_SB(1, 1), cB + hstepB + kstep, voffB);
    PG8_WAIT_V(6); PG8_BAR;
    for (;;) {
        const bool has_next = S.next(ui + 1, nxt);
        const char* nA = has_next ? PG8_ABASE(nxt) : cA; const char* nB = has_next ? PG8_BBASE(nxt) : cB;
        for (int t = 0; t < nt; t += 2) {
            const bool last = (t == nt - 2);
            const char* a1 = cA + (size_t)(t + 1) * kstep;
            const char* a2 = last ? nA : cA + (size_t)(t + 2) * kstep; const char* b2 = last ? nB : cB + (size_t)(t + 2) * kstep;
            const char* a3 = a2 + kstep; const char* b3 = b2 + kstep;
            PG8_LDB(B0, 0, 0); PG8_LDB(B1, 0, 1); PG8_SCHED; PG8_LDA(At, 0, 0); PG8_STAGE(PG8_SA(1, 1), a1 + hstepA, voffA);
            PG8_WAIT_V(8); PG8_WAIT_L(0); PG8_BAR; PG8_MMA(0, 0, At, B0); PG8_MMA(0, 1, At, B1); PG8_BAR; PG8_SCHED;
            PG8_LDA(At, 0, 1); PG8_STAGE(PG8_SB(0, 0), b2, voffB); PG8_STAGE(PG8_SB(0, 1), b2 + hstepB, voffB); PG8_STAGE(PG8_SA(0, 0), a2, voffA);
            PG8_WAIT_V(8); PG8_WAIT_L(0); PG8_BAR; PG8_MMA(1, 0, At, B0); PG8_MMA(1, 1, At, B1); PG8_BAR; PG8_SCHED;
            PG8_LDB(B0, 1, 0); PG8_LDB(B1, 1, 1); PG8_SCHED; PG8_LDA(At, 1, 0); PG8_STAGE(PG8_SA(0, 1), a2 + hstepA, voffA);
            PG8_WAIT_V(8); PG8_WAIT_L(0); PG8_BAR; PG8_MMA(0, 0, At, B0); PG8_MMA(0, 1, At, B1); PG8_BAR; PG8_SCHED;
            PG8_LDA(At, 1, 1); PG8_STAGE(PG8_SB(1, 0), b3, voffB); PG8_STAGE(PG8_SB(1, 1), b3 + hstepB, voffB); PG8_STAGE(PG8_SA(1, 0), a3, voffA);
            PG8_WAIT_V(8); PG8_WAIT_L(0); PG8_BAR; PG8_MMA(1, 0, At, B0); PG8_MMA(1, 1, At, B1); PG8_BAR; PG8_SCHED;
        }
        if constexpr (ALIGN_EPI) { if (wr == 0) PG8_BAR; }
        E(acc, cur, wr, wc, fr, fq);
        if (!has_next) break;
#pragma unroll
        for (int a = 0; a < 2; ++a)
#pragma unroll
            for (int b = 0; b < 2; ++b)
#pragma unroll
                for (int m = 0; m < 4; ++m)
#pragma unroll
                    for (int n = 0; n < 2; ++n) acc[a][b][m][n] = (f32x4){0.f, 0.f, 0.f, 0.f};
        cur = nxt; cA = nA; cB = nB; ++ui;
        if constexpr (ALIGN_EPI) { if (wr == 1) PG8_BAR; }
    }
    PG8_WAIT_V(0);
    if constexpr (!ALIGN_EPI) { if (wr == 0) PG8_BAR; }
    PG8_BAR;
#undef PG8_SA
#undef PG8_SB
#undef PG8_STAGE
#undef PG8_LDA
#undef PG8_LDB
#undef PG8_MMA
#undef PG8_WAIT_V
#undef PG8_WAIT_L
#undef PG8_BAR
#undef PG8_SCHED
#undef PG8_ABASE
#undef PG8_BBASE
}

#define EPI_ROWS_BEGIN(PERMV) const int row0 = u.pm * BM + wr * 64 + fr; const int colb = u.pn * BM + wc * 32 + ((PERMV) ? 8 : 4) * fq; \
    _Pragma("unroll") for (int ai = 0; ai < 2; ++ai) _Pragma("unroll") for (int m = 0; m < 4; ++m) { const int row = row0 + ai * HALF + m * 16; \
    _Pragma("unroll") for (int bj = 0; bj < 2; ++bj) { const int col = colb + bj * HALF; const f32x4 v0 = acc[ai][bj][m][0], v1 = acc[ai][bj][m][1];
#define EPI_ROWS_END } }

struct EpiInAB {
    static constexpr bool PERM = true;
    bf16_t* UA; bf16_t* UEXT;
    __device__ __forceinline__ void operator()(const f32x4 (&acc)[2][2][4][2], const Unit& u, int wr, int wc, int fr, int fq) const {
        EPI_ROWS_BEGIN(true)
            const u32x4 w = pack8(v0, v1);
            if (col < 512) { *(u32x4*)(UA + (size_t)row * 512 + col) = w; }
            else { const int cc = col - 512, g = cc >> 4, c0 = cc & 15, b = row >> 12, t = row & 4095;
                *(u32x4*)(UEXT + ((size_t)(g * 512 + b * 128 + (t >> 5)) * 640 + (t & 31) * 16 + c0)) = w; }
        EPI_ROWS_END
    }
};
struct EpiStateF32 {
    static constexpr bool PERM = false;
    float* S;
    __device__ __forceinline__ void operator()(const f32x4 (&acc)[2][2][4][2], const Unit& u, int wr, int wc, int fr, int fq) const {
        EPI_ROWS_BEGIN(false)
            if (bj == 0) { *(f32x4*)(S + (size_t)row * 128 + col) = v0; *(f32x4*)(S + (size_t)row * 128 + col + 16) = v1; }
        EPI_ROWS_END
    }
};
struct EpiBf16Plain {
    static constexpr bool PERM = true;
    bf16_t* O; int ldc;
    __device__ __forceinline__ void operator()(const f32x4 (&acc)[2][2][4][2], const Unit& u, int wr, int wc, int fr, int fq) const {
        EPI_ROWS_BEGIN(true)
            *(u32x4*)(O + (size_t)row * ldc + col) = pack8(v0, v1);
        EPI_ROWS_END
    }
};
struct EpiPool {
    static constexpr bool PERM = true;
    bf16_t* CAT; const float* scale;
    __device__ __forceinline__ void operator()(const f32x4 (&acc)[2][2][4][2], const Unit& u, int wr, int wc, int fr, int fq) const {
        EPI_ROWS_BEGIN(true)
            const f32x4 s0 = *(const f32x4*)(scale + col), s1 = *(const f32x4*)(scale + col + 4);
            *(u32x4*)(CAT + (size_t)row * 1024 + col) = pack8(v0 * s0, v1 * s1);
        EPI_ROWS_END
    }
};
__device__ __forceinline__ float gelu_tanh(float x) {
    const float a2 = 1.5957691216057308f * (x + 0.044715f * x * x * x);
    return x * __builtin_amdgcn_rcpf(1.f + __builtin_amdgcn_exp2f(-a2 * LOG2E));
}
struct EpiYGelu {
    static constexpr bool PERM = true;
    bf16_t* YB;
    __device__ __forceinline__ void operator()(const f32x4 (&acc)[2][2][4][2], const Unit& u, int wr, int wc, int fr, int fq) const {
        EPI_ROWS_BEGIN(true)
            const int g = row >> 9, rr = row & 511, b = rr >> 7, k = rr & 127, i = col >> 4, c0 = col & 15;
            f32x4 a = v0, c = v1;
#pragma unroll
            for (int e = 0; e < 4; ++e) { a[e] = gelu_tanh(a[e]); c[e] = gelu_tanh(c[e]); }
            *(u32x4*)(YB + ((size_t)(b * 4096 + 32 * k + i) * 512 + 16 * g + c0)) = pack8(a, c);
        EPI_ROWS_END
    }
};
struct EpiGlu {
    static constexpr bool PERM = true;
    bf16_t* CAT; const bf16_t* YB; const float* bias;
    __device__ __forceinline__ void operator()(const f32x4 (&acc)[2][2][4][2], const Unit& u, int wr, int wc, int fr, int fq) const {
        EPI_ROWS_BEGIN(true)
            const f32x4 b0 = *(const f32x4*)(bias + col), b1 = *(const f32x4*)(bias + col + 4);
            const u32x4 yw = *(const u32x4*)(YB + (size_t)row * 512 + col);
            f32x4 a = v0 + b0, c = v1 + b1;
#pragma unroll
            for (int e = 0; e < 4; ++e) {
                const unsigned wa = yw[e >> 1], wb = yw[2 + (e >> 1)];
                const float ya = (e & 1) ? __uint_as_float(wa & 0xffff0000u) : __uint_as_float(wa << 16);
                const float yc = (e & 1) ? __uint_as_float(wb & 0xffff0000u) : __uint_as_float(wb << 16);
                a[e] = ya * __builtin_amdgcn_rcpf(1.f + __builtin_amdgcn_exp2f(-a[e] * LOG2E));
                c[e] = yc * __builtin_amdgcn_rcpf(1.f + __builtin_amdgcn_exp2f(-c[e] * LOG2E));
            }
            *(u32x4*)(CAT + (size_t)row * 1024 + 512 + col) = pack8(a, c);
        EPI_ROWS_END
    }
};
struct EpiResid {
    static constexpr bool PERM = true;
    const bf16_t* xbin; float* xout; const float* gate;
    __device__ __forceinline__ void operator()(const f32x4 (&acc)[2][2][4][2], const Unit& u, int wr, int wc, int fr, int fq) const {
        const float* gb = gate + (size_t)((u.pm * BM) >> 12) * 3072;
        const size_t xboff = (u.pm < 32) ? (size_t)(WS_XB_LO / 2) : (size_t)(WS_XB_HI / 2) - (size_t)8192 * 1024;
        EPI_ROWS_BEGIN(true)
            const size_t o = (size_t)row * 1024 + col;
            const f32x4 g0 = *(const f32x4*)(gb + col), g1 = *(const f32x4*)(gb + col + 4);
            f32x4 x0, x1; unpack8(*(const u32x4*)(xbin + xboff + o), x0, x1);
            *(f32x4*)(xout + o) = x0 + (g0 + 1.f) * v0; *(f32x4*)(xout + o + 4) = x1 + (g1 + 1.f) * v1;
        EPI_ROWS_END
    }
};
struct EpiRelu2 {
    static constexpr bool PERM = true;
    bf16_t* HID;
    __device__ __forceinline__ void operator()(const f32x4 (&acc)[2][2][4][2], const Unit& u, int wr, int wc, int fr, int fq) const {
        EPI_ROWS_BEGIN(true)
            f32x4 a = v0, c = v1;
#pragma unroll
            for (int e = 0; e < 4; ++e) { const float p = fmaxf(a[e], 0.f), q = fmaxf(c[e], 0.f); a[e] = p * p; c[e] = q * q; }
            *(u32x4*)(HID + (size_t)row * FF + col) = pack8(a, c);
        EPI_ROWS_END
    }
};
struct EpiInCD {
    static constexpr bool PERM = true;
    bf16_t* PROJ; float* WI;
    __device__ __forceinline__ void operator()(const f32x4 (&acc)[2][2][4][2], const Unit& u, int wr, int wc, int fr, int fq) const {
        const float sc = (u.pn < 4) ? C2 : 1.f;
        EPI_ROWS_BEGIN(true)
            *(u32x4*)(PROJ + (size_t)row * PW + col) = pack8(v0 * sc, v1 * sc);
            if (col == PC_WI) { *(f32x4*)(WI + (size_t)row * 8) = v0; *(f32x4*)(WI + (size_t)row * 8 + 4) = v1; }
        EPI_ROWS_END
    }
};
template <bool XIN_F32, bool WRITE_XB = true> struct EpiResidNorm {
    static constexpr bool PERM = true;
    const float* xin; const bf16_t* xbin; bf16_t* xbout; const float* gate; const float* gs; bf16_t* H; float* SSQ;
    __device__ __forceinline__ void operator()(const f32x4 (&acc)[2][2][4][2], const Unit& u, int wr, int wc, int fr, int fq) const {
        const int b = (u.pm * BM) >> 12; const float* gb = gate + (size_t)b * 3072; const float* gsb = gs + (size_t)b * 1024;
        const int row0 = u.pm * BM + wr * 64 + fr, colb = u.pn * BM + wc * 32 + 8 * fq;
        const size_t xboff = (u.pm < 32) ? (size_t)(WS_XB_LO / 2) : (size_t)(WS_XB_HI / 2) - (size_t)8192 * 1024;
        float ss[8];
#pragma unroll
        for (int r = 0; r < 8; ++r) ss[r] = 0.f;
#pragma unroll
        for (int bj = 0; bj < 2; ++bj) { const int col = colb + bj * HALF;
            const f32x4 g0 = *(const f32x4*)(gb + col) + 1.f, g1 = *(const f32x4*)(gb + col + 4) + 1.f, s0 = *(const f32x4*)(gsb + col), s1 = *(const f32x4*)(gsb + col + 4);
#pragma unroll
            for (int ai = 0; ai < 2; ++ai)
#pragma unroll
                for (int m = 0; m < 4; ++m) { const size_t o = (size_t)(row0 + ai * HALF + m * 16) * 1024 + col;
                    f32x4 x0, x1;
                    if (XIN_F32) { x0 = *(const f32x4*)(xin + o); x1 = *(const f32x4*)(xin + o + 4); } else unpack8(*(const u32x4*)(xbin + xboff + o), x0, x1);
                    x0 = x0 + g0 * acc[ai][bj][m][0]; x1 = x1 + g1 * acc[ai][bj][m][1];
                    if (WRITE_XB) *(u32x4*)(xbout + xboff + o) = pack8(x0, x1);
                    ss[ai * 4 + m] += ((x0.x * x0.x + x0.y * x0.y) + (x0.z * x0.z + x0.w * x0.w)) + ((x1.x * x1.x + x1.y * x1.y) + (x1.z * x1.z + x1.w * x1.w));
                    *(u32x4*)(H + o) = pack8(x0 * s0, x1 * s1); } }
#pragma unroll
        for (int r = 0; r < 8; ++r) { float s = ss[r]; s += __shfl_xor(s, 16); s += __shfl_xor(s, 32);
            if (fq == 0) SSQ[(size_t)(row0 + (r >> 2) * HALF + (r & 3) * 16) * 16 + u.pn * 4 + wc] = s; }
    }
};
__device__ __forceinline__ void load_rstd(float (&rs)[8], const float* SSQ, int row0, int fq) {
#pragma unroll
    for (int r = 0; r < 8; ++r) { const f32x4 p = *(const f32x4*)(SSQ + (size_t)(row0 + (r >> 2) * HALF + (r & 3) * 16) * 16 + 4 * fq);
        float s = (p.x + p.y) + (p.z + p.w); s += __shfl_xor(s, 16); s += __shfl_xor(s, 32); rs[r] = 1.f / sqrtf(s * (1.f / 1024.f) + EPS); }
}
struct EpiRelu2N {
    static constexpr bool PERM = true;
    bf16_t* HID; const float* SSQ; const float* SW;
    int pm0; float rs0[8];
    __device__ __forceinline__ void operator()(const f32x4 (&acc)[2][2][4][2], const Unit& u, int wr, int wc, int fr, int fq) const {
        const int row0 = u.pm * BM + wr * 64 + fr, colb = u.pn * BM + wc * 32 + 8 * fq; const float* swb = SW + (size_t)((u.pm * BM) >> 12) * FF;
        float rs[8];
        if (u.pm == pm0) {
#pragma unroll
            for (int r = 0; r < 8; ++r) rs[r] = rs0[r];
        } else load_rstd(rs, SSQ, row0, fq);
#pragma unroll
        for (int bj = 0; bj < 2; ++bj) { const int col = colb + bj * HALF; const f32x4 s0 = *(const f32x4*)(swb + col), s1 = *(const f32x4*)(swb + col + 4);
#pragma unroll
            for (int ai = 0; ai < 2; ++ai)
#pragma unroll
                for (int m = 0; m < 4; ++m) { const float r = rs[ai * 4 + m]; f32x4 a = acc[ai][bj][m][0] * r + s0, c = acc[ai][bj][m][1] * r + s1;
#pragma unroll
                    for (int e = 0; e < 4; ++e) { const float p = fmaxf(a[e], 0.f), q = fmaxf(c[e], 0.f); a[e] = p * p; c[e] = q * q; }
                    *(u32x4*)(HID + (size_t)(row0 + ai * HALF + m * 16) * FF + col) = pack8(a, c); } }
    }
};
struct EpiInCDN {
    static constexpr bool PERM = true;
    bf16_t* PROJ; float* WI; const float* SSQ; const float* SW;
    int pm0; float rs0[8];
    __device__ __forceinline__ void operator()(const f32x4 (&acc)[2][2][4][2], const Unit& u, int wr, int wc, int fr, int fq) const {
        const int row0 = u.pm * BM + wr * 64 + fr, colb = u.pn * BM + wc * 32 + 8 * fq; const float* swb = SW + (size_t)((u.pm * BM) >> 12) * PW;
        const float sc = (u.pn < 4) ? C2 : 1.f;
        float rs[8];
        if (u.pm == pm0) {
#pragma unroll
            for (int r = 0; r < 8; ++r) rs[r] = rs0[r];
        } else load_rstd(rs, SSQ, row0, fq);
#pragma unroll
        for (int bj = 0; bj < 2; ++bj) { const int col = colb + bj * HALF; const f32x4 s0 = *(const f32x4*)(swb + col), s1 = *(const f32x4*)(swb + col + 4);
#pragma unroll
            for (int ai = 0; ai < 2; ++ai)
#pragma unroll
                for (int m = 0; m < 4; ++m) { const float r = rs[ai * 4 + m]; const int row = row0 + ai * HALF + m * 16; const f32x4 a = acc[ai][bj][m][0] * r + s0, c = acc[ai][bj][m][1] * r + s1;
                    *(u32x4*)(PROJ + (size_t)row * PW + col) = pack8(a * sc, c * sc);
                    if (col == PC_WI) { *(f32x4*)(WI + (size_t)row * 8) = a; *(f32x4*)(WI + (size_t)row * 8 + 4) = c; } } }
    }
};
}

namespace attn_body {
using bf16 = __hip_bfloat16;
constexpr int D = 64, PITCH = PW;
constexpr int NW = 8, QBLK = 32, QB = QBLK * NW, KVBLK = 64;
__device__ __forceinline__ int crow(int r, int hi) { return (r & 3) + 8 * (r >> 2) + 4 * hi; }
#define SBAR() __builtin_amdgcn_sched_barrier(0)
constexpr int NSLOT = 3, SLOTB = 8192;
constexpr int LDS_K = 0, LDS_V = NSLOT * SLOTB, LDS_WS = 2 * NSLOT * SLOTB, LDS_OST = LDS_WS + NW * 64 * 4, LDS_FLAG = LDS_OST + NW * 4096, LDS_BYTES = LDS_FLAG + 256;
constexpr float MASKV = -3.0e38f;
__device__ __forceinline__ void glds16(const void* gsrc, unsigned lds_dst) { unsigned keep;
  asm volatile("s_mov_b32 %0, m0\n\ts_mov_b32 m0, %2\n\ts_nop 0\n\tglobal_load_lds_dwordx4 %1, off\n\ts_mov_b32 m0, %0" : "=&s"(keep) : "v"(gsrc), "s"(lds_dst) : "memory"); }
__device__ __forceinline__ float max3f(float a, float b, float c) { float r; asm("v_max3_f32 %0, %1, %2, %3" : "=v"(r) : "v"(a), "v"(b), "v"(c)); return r; }
__device__ __forceinline__ float max2f(float a, float b) { float r; asm("v_max_f32_e32 %0, %1, %2" : "=v"(r) : "v"(a), "v"(b)); return r; }
__device__ __forceinline__ float fadd_s(float a, float b) { float r; asm("v_add_f32_e32 %0, %1, %2" : "=v"(r) : "v"(a), "v"(b)); return r; }
__device__ __forceinline__ float fsub_s(float a, float b) { float r; asm("v_sub_f32_e32 %0, %1, %2" : "=v"(r) : "v"(a), "v"(b)); return r; }
__device__ __forceinline__ unsigned cvtpk_s(float lo, float hi) { return cvtpk(lo, hi); }
#define WAIT_BAR(N) asm volatile("s_waitcnt vmcnt(" #N ") lgkmcnt(0)\n\ts_barrier" ::: "memory")

__device__ __forceinline__ void qkt(f32x16& p0, f32x16& p1, const char* Kslot, const bf16x8* qr, const f32x16& negm, int r32, int hi) {
  const char* kb = Kslot + hi * 1024 + r32 * 16;
  #pragma unroll
  for (int d0 = 0; d0 < 4; ++d0) {
    const bf16x8 b0 = *reinterpret_cast<const bf16x8*>(kb + d0 * 2048);
    const bf16x8 b1 = *reinterpret_cast<const bf16x8*>(kb + d0 * 2048 + 512);
    if (d0 == 0) { p0 = __builtin_amdgcn_mfma_f32_32x32x16_bf16(b0, qr[0], negm, 0, 0, 0); p1 = __builtin_amdgcn_mfma_f32_32x32x16_bf16(b1, qr[0], negm, 0, 0, 0); }
    else { p0 = __builtin_amdgcn_mfma_f32_32x32x16_bf16(b0, qr[d0], p0, 0, 0, 0); p1 = __builtin_amdgcn_mfma_f32_32x32x16_bf16(b1, qr[d0], p1, 0, 0, 0); } }
}
typedef __attribute__((address_space(3))) const char* lds_cptr;
typedef short v4i16_t __attribute__((ext_vector_type(4)));
__device__ __forceinline__ void kload8(bf16x8* kf, lds_cptr kp) {
  kf[0] = *(const LAS bf16x8*)(kp);        kf[1] = *(const LAS bf16x8*)(kp + 512);
  kf[2] = *(const LAS bf16x8*)(kp + 2048); kf[3] = *(const LAS bf16x8*)(kp + 2560);
  kf[4] = *(const LAS bf16x8*)(kp + 4096); kf[5] = *(const LAS bf16x8*)(kp + 4608);
  kf[6] = *(const LAS bf16x8*)(kp + 6144); kf[7] = *(const LAS bf16x8*)(kp + 6656);
}
__device__ __forceinline__ void kload2(bf16x8* kf, lds_cptr kp, int j) { kf[2 * j] = *(const LAS bf16x8*)(kp + j * 2048); kf[2 * j + 1] = *(const LAS bf16x8*)(kp + j * 2048 + 512); }
__device__ __forceinline__ s16x4 vtr(lds_cptr p) { return __builtin_bit_cast(s16x4, __builtin_amdgcn_ds_read_tr16_b64_v4i16((LAS v4i16_t*)p)); }
__device__ __forceinline__ float rowmax(const f32x16& p0, const f32x16& p1) {
  float a = max3f(p0[0], p0[1], p1[0]), b = max3f(p0[2], p0[3], p1[1]); a = max3f(a, p1[2], p1[3]);
  #pragma unroll
  for (int r = 4; r < 16; r += 4) { a = max3f(a, p0[r], p0[r + 1]); b = max3f(b, p0[r + 2], p0[r + 3]); a = max3f(a, p1[r], p1[r + 1]); b = max3f(b, p1[r + 2], p1[r + 3]); }
  const float m = max2f(a, b);
  auto rr = __builtin_amdgcn_permlane32_swap(__float_as_uint(m), __float_as_uint(m), false, false);
  return max2f(__uint_as_float(rr[0]), __uint_as_float(rr[1]));
}
__device__ __forceinline__ void pv(f32x16* o, int vb, bf16x8 pa0, bf16x8 pa1, bf16x8 pa2, bf16x8 pa3) {
  #pragma unroll
  for (int d0 = 0; d0 < 2; ++d0) { s16x4 lo[4], hi[4];
    #pragma unroll
    for (int ks = 0; ks < 4; ++ks) {
      asm volatile("ds_read_b64_tr_b16 %0,%1 offset:%c2" : "=&v"(lo[ks]) : "v"(vb), "i"(d0 * 4096 + ks * 1024) : "memory");
      asm volatile("ds_read_b64_tr_b16 %0,%1 offset:%c2" : "=&v"(hi[ks]) : "v"(vb), "i"(d0 * 4096 + ks * 1024 + 512) : "memory"); }
    asm volatile("s_waitcnt lgkmcnt(0)" ::: "memory"); SBAR();
    #define PK(k) (bf16x8){lo[k][0], lo[k][1], lo[k][2], lo[k][3], hi[k][0], hi[k][1], hi[k][2], hi[k][3]}
    o[d0] = __builtin_amdgcn_mfma_f32_32x32x16_bf16(pa0, PK(0), o[d0], 0, 0, 0);
    o[d0] = __builtin_amdgcn_mfma_f32_32x32x16_bf16(pa1, PK(1), o[d0], 0, 0, 0);
    o[d0] = __builtin_amdgcn_mfma_f32_32x32x16_bf16(pa2, PK(2), o[d0], 0, 0, 0);
    o[d0] = __builtin_amdgcn_mfma_f32_32x32x16_bf16(pa3, PK(3), o[d0], 0, 0, 0);
    #undef PK
  }
}
__device__ __forceinline__ void dsa_mask(f32x16& p0, f32x16& p1, unsigned long long w, float dbase, float sl2, int hi, float mref, bool past) {
  const unsigned lo = (unsigned)w >> (4 * hi), up = (unsigned)(w >> 32) >> (4 * hi);
  const float e0 = -__builtin_fmaf(sl2, dbase, mref), e1 = __builtin_fmaf(sl2, 32.f, e0);
  #pragma unroll
  for (int r = 0; r < 16; ++r) { const int kvc = (r & 3) + 8 * (r >> 2); p0[r] = __builtin_fmaf(sl2, (float)kvc, p0[r] + e0); p1[r] = __builtin_fmaf(sl2, (float)kvc, p1[r] + e1); }
  if (!past) { const float s2 = sl2 + sl2;
    #pragma unroll
    for (int r = 0; r < 16; ++r) { const int kvc = (r & 3) + 8 * (r >> 2); const float d0 = dbase - (float)kvc, d1 = d0 - 32.f;
      p0[r] = __builtin_fmaf(s2, __builtin_fminf(d0, 0.f), p0[r]); p1[r] = __builtin_fmaf(s2, __builtin_fminf(d1, 0.f), p1[r]); } }
  #pragma unroll
  for (int r = 0; r < 16; ++r) { const int kvc = (r & 3) + 8 * (r >> 2);
    const unsigned t0 = (unsigned)__builtin_amdgcn_sbfe((int)lo, kvc, 1), t1 = (unsigned)__builtin_amdgcn_sbfe((int)up, kvc, 1);
    float r0, r1;
    asm("v_bfi_b32 %0, %1, %2, %3" : "=v"(r0) : "v"(t0), "v"(p0[r]), "s"(MASKV)); asm("v_bfi_b32 %0, %1, %2, %3" : "=v"(r1) : "v"(t1), "v"(p1[r]), "s"(MASKV));
    p0[r] = r0; p1[r] = r1; }
}

#ifndef ATTN_STORE16
#define ATTN_STORE16(p, v) (*(u32x4*)(p) = (v))
#endif
template <int THRL> __device__ __forceinline__ void dsa_unit(int b, int h, int qb, const bf16* Q, const bf16* __restrict__ K, const bf16* __restrict__ V, bf16* O, const unsigned long long* __restrict__ MASK, char* shm) {
  int tid = threadIdx.x; asm volatile("" : "+v"(tid)); const int lane = tid & 63, r32 = lane & 31, hi = lane >> 5; const int wid = __builtin_amdgcn_readfirstlane(tid >> 6);
  const long rowbase = (long)b * SEQ; const int q0 = qb * QB;
  const bf16* Qw = Q + (rowbase + q0 + wid * QBLK) * PITCH + h * D;
  const bf16* Kh = K + rowbase * PITCH + h * D, *Vh = V + rowbase * PITCH + h * D;
  const unsigned lds0 = (unsigned)(uintptr_t)shm;
  float* wsf = (float*)(shm + LDS_WS) + wid * 64;
  const bf16* ksrc = Kh + (long)lane * PITCH + wid * 8;
  const bf16* vsrc = Vh + (long)(16 * (wid & 3) + (lane >> 2)) * PITCH + (wid >> 2) * 32 + (lane & 3) * 8;
  const unsigned kdst = lds0 + LDS_K + wid * 1024, vdst = lds0 + LDS_V + wid * 1024;
  #define DMA_K(t, slot) glds16(ksrc + (long)(t) * KVBLK * PITCH, (unsigned)__builtin_amdgcn_readfirstlane(kdst + (slot)))
  #define DMA_V(t, slot) glds16(vsrc + (long)(t) * KVBLK * PITCH, (unsigned)__builtin_amdgcn_readfirstlane(vdst + (slot)))
  const int vb0 = (int)(lds0 + LDS_V) + ((lane >> 4) & 1) * 32 + (lane & 3) * 8 + (4 * hi + ((lane & 15) >> 2)) * 64;
  const char* Kbase = shm + LDS_K; bf16x8 kf[8];
  const lds_cptr shm3 = (lds_cptr)shm; const lds_cptr kp0 = shm3 + LDS_K + hi * 1024 + r32 * 16; const lds_cptr vp0 = shm3 + LDS_V + ((lane >> 4) & 1) * 32 + (lane & 3) * 8 + (4 * hi + ((lane & 15) >> 2)) * 64;
  const int NT = (q0 + QB) / KVBLK;
  #define PT(t) (NT - 1 - (t))
  DMA_K(PT(0), 0); DMA_V(PT(0), 0); DMA_K(PT(1), SLOTB);
  bf16x8 qr[4];
  #pragma unroll
  for (int d0 = 0; d0 < 4; ++d0) qr[d0] = *reinterpret_cast<const bf16x8*>(&Qw[(long)r32 * PITCH + d0 * 16 + hi * 8]);
  float mhat = 0.f, l_reg = 0.f; f32x16 o[2]; o[0] = f32x16{}; o[1] = f32x16{}; const f32x16 zero16 = f32x16{};
  const int qrel = wid * QBLK + r32;
  const unsigned long long* mrow = MASK + ((size_t)(rowbase + q0 + qrel)) * 64;
  const float sl2 = __builtin_amdgcn_exp2f(-(float)(h + 1)) * LOG2E;
  const float dq = (float)(q0 + qrel - 4 * hi);
  #define CMASK(P0, P1, t, MW) dsa_mask(P0, P1, MW, dq - (float)(64 * PT(t)), sl2, hi, mhat, 64 * PT(t) + 64 <= q0 + wid * QBLK)
  bool resc = false;
  #define START(P0, P1) do { const float rm = rowmax(P0, P1); resc = false; \
    { const float dl = max2f(rm, -4096.f); mhat = fadd_s(mhat, dl); \
      _Pragma("unroll") for (int r = 0; r < 16; ++r) { P0[r] = fsub_s(P0[r], dl); P1[r] = fsub_s(P1[r], dl); } \
      } \
    _Pragma("unroll") for (int r = 0; r < 16; ++r) P0[r] = __builtin_amdgcn_exp2f(P0[r]); } while (0)
  #define RESC() do { if (resc) { asm volatile("s_waitcnt lgkmcnt(0)" ::: "memory"); \
      _Pragma("unroll") for (int d_ = 0; d_ < 2; ++d_) _Pragma("unroll") for (int r = 0; r < 16; ++r) o[d_][r] *= wsf[crow(r, hi)]; } } while (0)
  f32x16 pA0, pA1, pB0, pB1;
  int sl_prev = 0, sl_cur = 0, sl_next = SLOTB;
  #define ROT() do { sl_prev = sl_cur; sl_cur = sl_next; sl_next = (sl_next == (NSLOT - 1) * SLOTB) ? 0 : sl_next + SLOTB; } while (0)
  DMA_K(PT(2), 2 * SLOTB);
  WAIT_BAR(3);
  { const unsigned long long mw0 = mrow[PT(0)];
    qkt(pA0, pA1, Kbase, qr, zero16, r32, hi); asm volatile("s_nop 15\n\ts_nop 7" : "+v"(pA0), "+v"(pA1)); CMASK(pA0, pA1, 0, mw0); }
  START(pA0, pA1);
  _Pragma("unroll") for (int r = 0; r < 16; ++r) pA1[r] = __builtin_amdgcn_exp2f(pA1[r]);
  WAIT_BAR(0);
  DMA_K(PT(3), 0); DMA_V(PT(1), SLOTB);
  ROT();
  kload8(kf, kp0 + sl_cur);
  WAIT_BAR(2);
  s16x4 vlo[8], vhi[8]; u32x4 pw0, pw1, pw2, pw3;
  #define PKW(P, B) cvtpk_s(P[B], P[B + 1])
  #define PAF(k) __builtin_bit_cast(bf16x8, pw##k)
  #define VFR(i) (bf16x8){vlo[i][0], vlo[i][1], vlo[i][2], vlo[i][3], vhi[i][0], vhi[i][1], vhi[i][2], vhi[i][3]}
  #define PIN(x) asm volatile("" : "+v"(x))
  #define MX3(a, b, c) __builtin_fmaxf(__builtin_fmaxf((a), (b)), (c))
  #define GAPA(MF, A0, A1, A2, A3, W0, W1, PW_) do { MF; sacc += A0; sacc += A1; sacc += A2; sacc += A3; PIN(sacc); W0; W1; PIN(PW_); SBAR(); } while (0)
  #define EX(v) __builtin_amdgcn_exp2f(v)
  #define GAPB(MF, X, B) do { MF; X[B] = EX(X[B]); X[B + 1] = EX(X[B + 1]); X[B + 2] = EX(X[B + 2]); X[B + 3] = EX(X[B + 3]); PIN(X); SBAR(); } while (0)
  #define VRD(i) do { vlo[i] = vtr(vp_ + (((i) >> 2) * 4096 + ((i) & 3) * 1024)); vhi[i] = vtr(vp_ + (((i) >> 2) * 4096 + ((i) & 3) * 1024 + 512)); } while (0)
  #define KRD(G, j) do { if (G) { kload2(kf, kp0 + sl_next, j); SBAR(); } } while (0)
  #define STEP(C0, C1, P0, P1, t, GK, GV, GL) do { SBAR(); \
    const unsigned long long mw_ = mwn; mwn = mrow[PT((t) + 1)]; \
    const lds_cptr vp_ = vp0 + sl_prev; \
    VRD(0); SBAR(); float sacc = (P0[0] + P0[1]); \
    GAPA(C0 = __builtin_amdgcn_mfma_f32_32x32x16_bf16(kf[0], qr[0], zero16, 0, 0, 0), P0[2], P0[3], P0[4], P0[5],     pw0[0] = PKW(P0, 0), pw0[1] = PKW(P0, 2), pw0); \
    VRD(4); SBAR(); GAPA(C1 = __builtin_amdgcn_mfma_f32_32x32x16_bf16(kf[1], qr[0], zero16, 0, 0, 0), P0[6], P0[7], P0[8], P0[9],     pw0[2] = PKW(P0, 4), pw0[3] = PKW(P0, 6), pw0); \
    VRD(1); SBAR(); GAPA(C0 = __builtin_amdgcn_mfma_f32_32x32x16_bf16(kf[2], qr[1], C0, 0, 0, 0),   P0[10], P0[11], P0[12], P0[13], pw1[0] = PKW(P0, 8), pw1[1] = PKW(P0, 10), pw1); \
    VRD(5); SBAR(); GAPA(C1 = __builtin_amdgcn_mfma_f32_32x32x16_bf16(kf[3], qr[1], C1, 0, 0, 0),   P0[14], P0[15], P1[0], P1[1],   pw1[2] = PKW(P0, 12), pw1[3] = PKW(P0, 14), pw1); \
    VRD(2); SBAR(); GAPA(C0 = __builtin_amdgcn_mfma_f32_32x32x16_bf16(kf[4], qr[2], C0, 0, 0, 0),   P1[2], P1[3], P1[4], P1[5],     pw2[0] = PKW(P1, 0), pw2[1] = PKW(P1, 2), pw2); \
    VRD(6); SBAR(); GAPA(C1 = __builtin_amdgcn_mfma_f32_32x32x16_bf16(kf[5], qr[2], C1, 0, 0, 0),   P1[6], P1[7], P1[8], P1[9],     pw2[2] = PKW(P1, 4), pw2[3] = PKW(P1, 6), pw2); \
    VRD(3); SBAR(); GAPA(C0 = __builtin_amdgcn_mfma_f32_32x32x16_bf16(kf[6], qr[3], C0, 0, 0, 0),   P1[10], P1[11], P1[12], P1[13], pw3[0] = PKW(P1, 8), pw3[1] = PKW(P1, 10), pw3); \
    VRD(7); SBAR(); GAPA(C1 = __builtin_amdgcn_mfma_f32_32x32x16_bf16(kf[7], qr[3], C1, 0, 0, 0),   P1[14], P1[15], 0.f, 0.f,       pw3[2] = PKW(P1, 12), pw3[3] = PKW(P1, 14), pw3); \
    l_reg += sacc; \
    CMASK(C0, C1, t, mw_); \
    if (GK) { DMA_K(PT((t) + 3), sl_cur); } if (GV) { DMA_V(PT((t) + 1), sl_next); } \
    { float a = MX3(C0[0], C0[1], C1[0]), b_ = MX3(C0[2], C0[3], C1[1]); a = MX3(a, C1[2], C1[3]); \
      _Pragma("unroll") for (int r = 4; r < 16; r += 4) { a = MX3(a, C0[r], C0[r + 1]); b_ = MX3(b_, C0[r + 2], C0[r + 3]); a = MX3(a, C1[r], C1[r + 1]); b_ = MX3(b_, C1[r + 2], C1[r + 3]); } \
      float rm = __builtin_fmaxf(a, b_); { auto rr = __builtin_amdgcn_permlane32_swap(__float_as_uint(rm), __float_as_uint(rm), false, false); rm = __builtin_fmaxf(__uint_as_float(rr[0]), __uint_as_float(rr[1])); } \
      resc = false; \
      if (__builtin_expect(__any(rm > (float)THRL), 0)) { const float dl = __builtin_fmaxf(rm, 0.f); mhat += dl; \
        _Pragma("unroll") for (int r = 0; r < 16; ++r) { C0[r] -= dl; C1[r] -= dl; } \
        const float f = __builtin_amdgcn_exp2f(-dl); l_reg *= f; if (hi == 0) wsf[r32] = f; resc = true; } } \
    SBAR(); \
    GAPB(o[0] = __builtin_amdgcn_mfma_f32_32x32x16_bf16(PAF(0), VFR(0), o[0], 0, 0, 0), C0, 0); \
    GAPB(o[1] = __builtin_amdgcn_mfma_f32_32x32x16_bf16(PAF(0), VFR(4), o[1], 0, 0, 0), C0, 4); \
    KRD(GL, 0); GAPB(o[0] = __builtin_amdgcn_mfma_f32_32x32x16_bf16(PAF(1), VFR(1), o[0], 0, 0, 0), C0, 8); \
    KRD(GL, 1); GAPB(o[1] = __builtin_amdgcn_mfma_f32_32x32x16_bf16(PAF(1), VFR(5), o[1], 0, 0, 0), C0, 12); \
    KRD(GL, 2); GAPB(o[0] = __builtin_amdgcn_mfma_f32_32x32x16_bf16(PAF(2), VFR(2), o[0], 0, 0, 0), C1, 0); \
    KRD(GL, 3); GAPB(o[1] = __builtin_amdgcn_mfma_f32_32x32x16_bf16(PAF(2), VFR(6), o[1], 0, 0, 0), C1, 4); \
    GAPB(o[0] = __builtin_amdgcn_mfma_f32_32x32x16_bf16(PAF(3), VFR(3), o[0], 0, 0, 0), C1, 8); \
    GAPB(o[1] = __builtin_amdgcn_mfma_f32_32x32x16_bf16(PAF(3), VFR(7), o[1], 0, 0, 0), C1, 12); \
    } while (0)
  int t = 1;
  unsigned long long mwn = mrow[PT(1)];
  for (; t + 5 < NT; t += 2) {
    STEP(pB0, pB1, pA0, pA1, t, true, true, true);     WAIT_BAR(2); RESC(); ROT();
    STEP(pA0, pA1, pB0, pB1, t + 1, true, true, true); WAIT_BAR(2); RESC(); ROT();
  }
  #define ENDW(tt) do { if ((tt) + 3 < NT) { WAIT_BAR(2); } else if ((tt) + 2 < NT) { WAIT_BAR(1); } else { WAIT_BAR(0); } } while (0)
  for (; t + 1 < NT; t += 2) {
    STEP(pB0, pB1, pA0, pA1, t, (t + 3 < NT), (t + 1 < NT), (t + 1 < NT));       ENDW(t);     RESC(); ROT();
    STEP(pA0, pA1, pB0, pB1, t + 1, (t + 4 < NT), (t + 2 < NT), (t + 2 < NT));   ENDW(t + 1); RESC(); ROT();
  }
  STEP(pB0, pB1, pA0, pA1, NT - 1, false, false, false); RESC();
  { float sacc = pB0[0] + pB0[1]; _Pragma("unroll") for (int r = 2; r < 16; ++r) sacc += pB0[r]; _Pragma("unroll") for (int r = 0; r < 16; ++r) sacc += pB1[r]; l_reg += sacc;
    pw0 = (u32x4){PKW(pB0, 0), PKW(pB0, 2), PKW(pB0, 4), PKW(pB0, 6)}; pw1 = (u32x4){PKW(pB0, 8), PKW(pB0, 10), PKW(pB0, 12), PKW(pB0, 14)}; pw2 = (u32x4){PKW(pB1, 0), PKW(pB1, 2), PKW(pB1, 4), PKW(pB1, 6)}; pw3 = (u32x4){PKW(pB1, 8), PKW(pB1, 10), PKW(pB1, 12), PKW(pB1, 14)};
    SBAR(); pv(o, vb0 + sl_cur, PAF(0), PAF(1), PAF(2), PAF(3)); }
  #undef PKW
  #undef PAF
  #undef VFR
  #undef PIN
  #undef MX3
  #undef GAPA
  #undef GAPB
  #undef EX
  #undef VRD
  #undef KRD
  #undef STEP
  #undef ENDW
  { auto rr = __builtin_amdgcn_permlane32_swap(__float_as_uint(l_reg), __float_as_uint(l_reg), false, false); l_reg = __uint_as_float(rr[0]) + __uint_as_float(rr[1]); }
  if (hi == 0) wsf[32 + r32] = l_reg; asm volatile("s_waitcnt lgkmcnt(0)" ::: "memory");
  float rli[16];
  #pragma unroll
  for (int r = 0; r < 16; ++r) rli[r] = __builtin_amdgcn_rcpf(wsf[32 + crow(r, hi)]);
  bf16* Ow = O + (rowbase + q0 + wid * QBLK) * PITCH + h * D;
  { bf16* stg = (bf16*)(shm + LDS_OST) + wid * 2048;
    #pragma unroll
    for (int r = 0; r < 16; ++r) { const int orow = crow(r, hi);
      #pragma unroll
      for (int d0 = 0; d0 < 2; ++d0) stg[orow * 64 + d0 * 32 + r32] = __float2bfloat16(o[d0][r] * rli[r]); }
    asm volatile("s_waitcnt lgkmcnt(0)" ::: "memory");
    #pragma unroll
    for (int i = 0; i < 4; ++i) { const int row = i * 8 + (lane >> 3), ch = lane & 7; const u32x4 v = *(const u32x4*)(stg + row * 64 + ch * 8); ATTN_STORE16(Ow + (long)row * PITCH + ch * 8, v); } }
  asm volatile("s_waitcnt lgkmcnt(0)\n\ts_barrier" ::: "memory");
  #undef PT
  #undef CMASK
  #undef START
  #undef RESC
  #undef ROT
}

template <bool EARLY> __device__ __forceinline__ void sb_unit(int b, int h, int qb, const bf16* Q, const bf16* __restrict__ K, const bf16* __restrict__ V, bf16* O, char* shm) {
  int tid = threadIdx.x; asm volatile("" : "+v"(tid)); const int lane = tid & 63, r32 = lane & 31, hi = lane >> 5; const int wid = __builtin_amdgcn_readfirstlane(tid >> 6);
  const long rowbase = (long)b * SEQ; const int q0 = qb * QB;
  const bf16* Qw = Q + (rowbase + q0 + wid * QBLK) * PITCH + h * D;
  const bf16* Kh = K + rowbase * PITCH + h * D, *Vh = V + rowbase * PITCH + h * D;
  const unsigned lds0 = (unsigned)(uintptr_t)shm;
  const bf16* ksrc = Kh + (long)lane * PITCH + wid * 8;
  const bf16* vsrc = Vh + (long)(16 * (wid & 3) + (lane >> 2)) * PITCH + (wid >> 2) * 32 + (lane & 3) * 8;
  const unsigned kdst = lds0 + LDS_K + wid * 1024, vdst = lds0 + LDS_V + wid * 1024;
  const int vb0 = (int)(lds0 + LDS_V) + ((lane >> 4) & 1) * 32 + (lane & 3) * 8 + (4 * hi + ((lane & 15) >> 2)) * 64;
  volatile unsigned* flags = (volatile unsigned*)(shm + LDS_FLAG);
  const int NT = (q0 + QB) / KVBLK;
  DMA_K(NT - 1, 0); DMA_V(NT - 1, 0);
  bf16x8 qr[4];
  #pragma unroll
  for (int d0 = 0; d0 < 4; ++d0) qr[d0] = *reinterpret_cast<const bf16x8*>(&Qw[(long)r32 * PITCH + d0 * 16 + hi * 8]);
  f32x16 o[2]; o[0] = f32x16{}; o[1] = f32x16{};
  const f32x16 zero16 = f32x16{};
  const int tq = q0 + wid * QBLK + r32;
  const int tq_lo = q0 + wid * QBLK;
  float carry = 0.f;
  bool wdone = false;
  int it = 0;
  for (int tt = NT - 1; tt >= 0; --tt, ++it) {
    const int cur = (it % 3) * SLOTB, nxtb = ((it + 1) % 3) * SLOTB;
    if (tt > 0) { DMA_K(tt - 1, nxtb); DMA_V(tt - 1, nxtb); WAIT_BAR(2); } else { WAIT_BAR(0); }
    if (EARLY && it > 0) { unsigned all = 1u;
      #pragma unroll
      for (int w8 = 0; w8 < 8; ++w8) all &= flags[((it - 1) & 1) * 8 + w8];
      if (all) break; }
    const int kbase = 64 * tt;
    if (kbase < tq_lo + 31 && !wdone) {
      f32x16 p0, p1;
      qkt(p0, p1, shm + LDS_K + cur, qr, zero16, r32, hi);
      const int lim = tq - kbase - 4 * hi;
      float lk0[16], lk1[16];
      #pragma unroll
      for (int r = 0; r < 16; ++r) { const int kvc = (r & 3) + 8 * (r >> 2);
        const float z0 = __builtin_amdgcn_fmed3f(p0[r], -120.f, 120.f), z1 = __builtin_amdgcn_fmed3f(p1[r], -120.f, 120.f);
        const float s0 = __builtin_amdgcn_logf(1.f + __builtin_amdgcn_exp2f(z0)), s1 = __builtin_amdgcn_logf(1.f + __builtin_amdgcn_exp2f(z1));
        const bool v0 = kvc < lim, v1 = kvc + 32 < lim;
        lk0[r] = v0 ? -s0 : 0.f; lk1[r] = v1 ? -s1 : 0.f;
        p0[r] = v0 ? z0 - s0 : MASKV; p1[r] = v1 ? z1 - s1 : MASKV; }
      float gs[8];
      #pragma unroll
      for (int a = 0; a < 4; ++a) { gs[a] = (lk0[4 * a] + lk0[4 * a + 1]) + (lk0[4 * a + 2] + lk0[4 * a + 3]); gs[4 + a] = (lk1[4 * a] + lk1[4 * a + 1]) + (lk1[4 * a + 2] + lk1[4 * a + 3]); }
      float S[16];
      #pragma unroll
      for (int j = 0; j < 8; ++j) { auto rr = __builtin_amdgcn_permlane32_swap(__float_as_uint(gs[j]), __float_as_uint(gs[j]), false, false); S[2 * j] = __uint_as_float(rr[0]); S[2 * j + 1] = __uint_as_float(rr[1]); }
      float suf[16]; suf[15] = carry;
      #pragma unroll
      for (int G = 14; G >= 0; --G) suf[G] = suf[G + 1] + S[G + 1];
      const float total = suf[0] + S[0];
      #pragma unroll
      for (int j = 0; j < 8; ++j) { float ag = suf[2 * j + 1] + (hi ? 0.f : S[2 * j + 1]);
        if (j < 4) {
          #pragma unroll
          for (int i = 3; i >= 0; --i) { p0[4 * j + i] = __builtin_amdgcn_exp2f(p0[4 * j + i] + ag); ag += lk0[4 * j + i]; }
        } else {
          #pragma unroll
          for (int i = 3; i >= 0; --i) { p1[4 * (j - 4) + i] = __builtin_amdgcn_exp2f(p1[4 * (j - 4) + i] + ag); ag += lk1[4 * (j - 4) + i]; }
        } }
      carry = total;
      u32x4 pw0 = (u32x4){cvtpk(p0[0], p0[1]), cvtpk(p0[2], p0[3]), cvtpk(p0[4], p0[5]), cvtpk(p0[6], p0[7])};
      u32x4 pw1 = (u32x4){cvtpk(p0[8], p0[9]), cvtpk(p0[10], p0[11]), cvtpk(p0[12], p0[13]), cvtpk(p0[14], p0[15])};
      u32x4 pw2 = (u32x4){cvtpk(p1[0], p1[1]), cvtpk(p1[2], p1[3]), cvtpk(p1[4], p1[5]), cvtpk(p1[6], p1[7])};
      u32x4 pw3 = (u32x4){cvtpk(p1[8], p1[9]), cvtpk(p1[10], p1[11]), cvtpk(p1[12], p1[13]), cvtpk(p1[14], p1[15])};
      pv(o, vb0 + cur, __builtin_bit_cast(bf16x8, pw0), __builtin_bit_cast(bf16x8, pw1), __builtin_bit_cast(bf16x8, pw2), __builtin_bit_cast(bf16x8, pw3));
      wdone = EARLY && __all(carry < -160.f);
    }
    if (EARLY) { if (lane == 0) flags[(it & 1) * 8 + wid] = wdone ? 1u : 0u; }
  }
  asm volatile("s_waitcnt lgkmcnt(0)\n\ts_barrier" ::: "memory");
  asm volatile("s_waitcnt vmcnt(0)" ::: "memory");
  bf16* Ow = O + (rowbase + q0 + wid * QBLK) * PITCH + h * D;
  { bf16* stg = (bf16*)(shm + LDS_OST) + wid * 2048;
    #pragma unroll
    for (int r = 0; r < 16; ++r) { const int orow = crow(r, hi);
      #pragma unroll
      for (int d0 = 0; d0 < 2; ++d0) stg[orow * 64 + d0 * 32 + r32] = __float2bfloat16(o[d0][r]); }
    asm volatile("s_waitcnt lgkmcnt(0)" ::: "memory");
    #pragma unroll
    for (int i = 0; i < 4; ++i) { const int row = i * 8 + (lane >> 3), ch = lane & 7; const u32x4 v = *(const u32x4*)(stg + row * 64 + ch * 8); ATTN_STORE16(Ow + (long)row * PITCH + ch * 8, v); } }
  asm volatile("s_waitcnt vmcnt(0) lgkmcnt(0)\n\ts_barrier" ::: "memory");
}
#undef DMA_K
#undef DMA_V
#undef SBAR
#undef WAIT_BAR
constexpr int ATTN_LDS_BYTES = LDS_BYTES;
}

constexpr int NWAVES = 8;
#ifndef MK_PER_PHASE
#define MK_PER_PHASE 0
#endif
#ifndef SB_EARLY
#define SB_EARLY 1
#endif
constexpr int NPHASE = 20;

constexpr size_t MiB = 1u << 20;
constexpr size_t WS_CTL = 0, CTL_ZERO_BYTES = 64 * 1024;
constexpr int NKS = 32;
constexpr size_t WS_MODP = 112 * MiB + 100 * MiB;
constexpr size_t WS_MODF = 3 * MiB;
constexpr size_t WS_APOW = 3 * MiB + 512 * 1024;
constexpr size_t WS_GS = 3 * MiB + 256 * 1024;
constexpr size_t WS_SW = 3 * MiB + 320 * 1024;
constexpr size_t WS_SSQ = 1 * MiB;
constexpr int SW_OFF1 = 4 * 4096, SW_OFF2 = 4 * 4096 + 4 * PW;
constexpr size_t WS_W_ABIN = 4 * MiB, WS_W_ABOUT = 6 * MiB, WS_W_GLU = 8 * MiB, WS_W_POOL = 8 * MiB + 512 * 1024;
constexpr size_t WS_BTY = 9 * MiB;
constexpr size_t WS_BTS = 29 * MiB;
constexpr size_t WS_W1 = 37 * MiB;
constexpr size_t WS_W2 = 53 * MiB;
constexpr size_t WS_W_CDIN = 69 * MiB;
constexpr size_t WS_W_CDOUT = 77 * MiB;
constexpr size_t WS_WIF = 79 * MiB;
constexpr size_t WS_H = 80 * MiB;
constexpr size_t WS_BIG = 112 * MiB;
constexpr size_t WS_UA = WS_BIG, WS_PA = WS_BIG + 16 * MiB, WS_UEXT = WS_BIG + 32 * MiB, WS_SST = WS_BIG + 53 * MiB, WS_YB = WS_BIG + 61 * MiB, WS_CAT = WS_BIG + 77 * MiB;
constexpr size_t WS_PROJ = WS_BIG, WS_MASK = WS_BIG + 120 * MiB;
constexpr size_t WS_END = 256 * MiB;
static_assert(WS_CAT + 32 * MiB <= WS_BIG + 128 * MiB && WS_UEXT + (size_t)32 * 512 * 640 * 2 <= WS_SST && WS_SST + 8 * MiB <= WS_YB, "ws map");
static_assert(WS_MASK + 8 * MiB <= WS_BIG + 128 * MiB && (size_t)MTOK * PW * 2 <= 120 * MiB && WS_BIG + 128 * MiB <= WS_END, "ws map");
constexpr int CW_BAR = 1024;

constexpr int RING_OFF = 0, RING_BYTES = 131072;
constexpr int LDSCTL_OFF = RING_BYTES, MISC_OFF = LDSCTL_OFF + 320;
constexpr int LDS_BYTES = 147456;

typedef GAS unsigned gu32;
#define RLX_AGENT __ATOMIC_RELAXED, __HIP_MEMORY_SCOPE_AGENT

#define XB_TMO      128
#define XB_XCNT(j)  (256  + 64 * (j))
#define XB_XSUB(j)  (1280 + 64 * (j))
#define XB_XGEN(j)  (2304 + 64 * (j))
#define XB_TOP      3328
#define XB_TOPGEN   3392
#define XCD_BAR_WORDS 3456
#define XB_SPIN_CAP (1u << 20)
__device__ __forceinline__ unsigned xb_ld(unsigned* p)              { return __hip_atomic_load(p, __ATOMIC_RELAXED, __HIP_MEMORY_SCOPE_AGENT); }
__device__ __forceinline__ unsigned xb_add(unsigned* p, unsigned v) { return __hip_atomic_fetch_add(p, v, __ATOMIC_RELAXED, __HIP_MEMORY_SCOPE_AGENT); }
__device__ __forceinline__ unsigned xb_xcc_id() { return (unsigned)__builtin_amdgcn_s_getreg((3 << 11) | 20) & 0xFu; }
#define XB_SPIN(cond, bar) do { unsigned _sp = 0; while (cond) { __builtin_amdgcn_s_sleep(1); \
    if ((++_sp & 255u) == 0u) { if (xb_ld(&(bar)[XB_TMO])) break; if (_sp > XB_SPIN_CAP) { atomicAdd(&(bar)[XB_TMO], 1u); break; } } } } while (0)
struct XcdBarrier { unsigned* bar; unsigned x; volatile LAS unsigned* st; };
__device__ __forceinline__ XcdBarrier xcd_barrier_post(unsigned* bar, volatile LAS unsigned* st) {
    XcdBarrier b; b.bar = bar; b.x = xb_xcc_id(); b.st = st;
    if (threadIdx.x == 0) (void)xb_add(&bar[XB_XCNT(b.x)], 1u);
    return b;
}
__device__ __forceinline__ void xcd_barrier_complete(unsigned* bar, unsigned x, unsigned& nloc, unsigned& nx) {
    const unsigned G = gridDim.x * gridDim.y * gridDim.z;
    unsigned sum, cnt, mine, sp = 0u;
    for (;;) {
        sum = 0u; cnt = 0u; mine = 0u;
#pragma unroll
        for (unsigned j = 0; j < 16; ++j) { const unsigned c = xb_ld(&bar[XB_XCNT(j)]); sum += c; cnt += (c > 0u) ? 1u : 0u; mine = (j == x) ? c : mine; }
        if (sum == G) break;
        __builtin_amdgcn_s_sleep(1);
        if ((++sp & 255u) == 0u) { if (xb_ld(&bar[XB_TMO])) break; if (sp > XB_SPIN_CAP) { atomicAdd(&bar[XB_TMO], 1u); break; } }
    }
    nloc = mine > 0u ? mine : 1u; nx = cnt > 0u ? cnt : 1u;
}
__device__ __forceinline__ void xcd_barrier(const XcdBarrier& b) {
    asm volatile("s_waitcnt vmcnt(0)" ::: "memory");
    __syncthreads();
    if (threadIdx.x == 0) {
        unsigned* bar = b.bar;
        __builtin_amdgcn_s_waitcnt(0);
        unsigned nloc = b.st[0], nx = b.st[1];
        if (nloc == 0u) { xcd_barrier_complete(bar, b.x, nloc, nx); b.st[0] = nloc; b.st[1] = nx; }
        const unsigned old = xb_add(&bar[XB_XSUB(b.x)], 1u);
        const unsigned gen = old / nloc;
        if (old + 1u == (gen + 1u) * nloc) {
            asm volatile("buffer_wbl2 sc1\n\tbuffer_inv sc1\n\ts_waitcnt vmcnt(0)" ::: "memory");
            const unsigned og = xb_add(&bar[XB_TOP], 1u);
            const unsigned tg = og / nx;
            if (og + 1u == (tg + 1u) * nx) xb_add(&bar[XB_TOPGEN], 1u);
            else XB_SPIN(xb_ld(&bar[XB_TOPGEN]) == tg, bar);
            xb_add(&bar[XB_XGEN(b.x)], 1u);
            asm volatile("s_waitcnt vmcnt(0)" ::: "memory");
        } else {
            asm volatile("buffer_inv sc1" ::: "memory");
            XB_SPIN(xb_ld(&bar[XB_XGEN(b.x)]) == gen, bar);
            asm volatile("s_waitcnt vmcnt(0)" ::: "memory");
        }
    }
    __syncthreads();
}

enum { I_X = 0, I_C, I_NORMG, I_ADAW, I_ADAB, I_W1, I_W2, I_ABIN, I_ABOUT, I_POOLW, I_POOLS, I_LRE, I_LIM, I_LOGDT, I_BRE, I_BIM, I_CRE, I_CIM, I_SSMD, I_GLUW, I_GLUB, I_CDIN, I_CDOUT, I_FING, N_IN };
struct Args { const float* in[N_IN]; float* out; unsigned char* ws; int ph_lo, ph_hi; };

struct Frame {
    LAS unsigned char* lds;
    int tid, lane, wave, vcu, G;
};

__device__ __forceinline__ float wave_sum(float v) {
#pragma unroll
    for (int o = 1; o < 64; o <<= 1) v += __shfl_xor(v, o);
    return v;
}
#define LDS_WAIT() asm volatile("s_waitcnt lgkmcnt(0)" ::: "memory")

__device__ __forceinline__ void transpose_item(const float* W, int ldw, int n0, int ncols, int k0, bf16_t* WT, int ldo, int drow0, LAS float* scr, int lane) {
    const int r8 = lane >> 3, c4 = (lane & 7) * 4;
    f32x4 v[8];
#pragma unroll
    for (int i = 0; i < 8; ++i) v[i] = (c4 < ncols) ? *(const f32x4*)(W + (size_t)(k0 + r8 + 8 * i) * ldw + n0 + c4) : (f32x4){0.f, 0.f, 0.f, 0.f};
#pragma unroll
    for (int i = 0; i < 8; ++i) { LAS float* d = scr + (r8 + 8 * i) * 33 + c4; d[0] = v[i].x; d[1] = v[i].y; d[2] = v[i].z; d[3] = v[i].w; }
    LDS_WAIT(); asm volatile("" ::: "memory");
    const int c = lane & 7;
#pragma unroll
    for (int j = 0; j < 4; ++j) { const int n = (lane >> 3) + 8 * j; const LAS float* s = scr + (8 * c) * 33 + n;
        u32x4 o; o.x = cvtpk(s[0 * 33], s[1 * 33]); o.y = cvtpk(s[2 * 33], s[3 * 33]); o.z = cvtpk(s[4 * 33], s[5 * 33]); o.w = cvtpk(s[6 * 33], s[7 * 33]);
        if (n < ncols) *(u32x4*)(WT + (size_t)(drow0 + n) * ldo + k0 + 8 * c) = o; }
    LDS_WAIT(); asm volatile("" ::: "memory");
}
__device__ __forceinline__ void transpose_full(const float* W, int K, int N, bf16_t* WT, int item, LAS float* scr, int lane) {
    const int nblk = N / 32, kb = item / nblk, nb = item % nblk;
    transpose_item(W, N, 32 * nb, 32, 64 * kb, WT, K, 32 * nb, scr, lane);
}

__device__ __forceinline__ void sincos_d(double x, float& s, float& c) {
    const double inv2pi = 0.15915494309189535, tp_hi = 6.283185307179586, tp_lo = 2.4492935982947064e-16;
    const double k = __builtin_rint(x * inv2pi);
    double r = __builtin_fma(-k, tp_hi, x); r = __builtin_fma(-k, tp_lo, r);
    const double r2 = r * r;
    double vs = 1.0, vc = 1.0;
#pragma unroll
    for (int j = 15; j >= 1; --j) { vs = 1.0 - r2 * (1.0 / (double)((2 * j) * (2 * j + 1))) * vs; vc = 1.0 - r2 * (1.0 / (double)((2 * j - 1) * (2 * j))) * vc; }
    s = (float)(r * vs); c = (float)vc;
}

__device__ __forceinline__ void s5_tables(const Frame& F, const Args& a, int g, int qtr) {
    LAS float* AP = (LAS float*)(F.lds);
    LAS float* BB = AP + 33 * 64 * 2;
    LAS float* CL = BB + 64 * 16 * 2;
    LAS float* KT = CL + 16 * 64 * 2;
    const float* lre = a.in[I_LRE]; const float* lim = a.in[I_LIM]; const float* ldt = a.in[I_LOGDT];
    const float* bre = a.in[I_BRE]; const float* bim = a.in[I_BIM]; const float* cre = a.in[I_CRE]; const float* cim = a.in[I_CIM]; const float* dsk = a.in[I_SSMD];
    bf16_t* BTY = (bf16_t*)(a.ws + WS_BTY); bf16_t* BTS = (bf16_t*)(a.ws + WS_BTS); float* APOW = (float*)(a.ws + WS_APOW);
    const float dt = expf(ldt[g]);
    __syncthreads();
    for (int idx = F.tid; idx < 33 * 64; idx += 512) { const int n = idx >> 6, p = idx & 63;
        const float lr = lre[g * 64 + p], li = lim[g * 64 + p];
        const float mag = expf((float)n * lr * dt); float s, c; sincos_d((double)li * (double)dt * (double)n, s, c);
        AP[idx * 2] = mag * c; AP[idx * 2 + 1] = mag * s; }
    for (int idx = F.tid; idx < 16 * 64; idx += 512) { CL[idx * 2] = cre[g * 1024 + idx]; CL[idx * 2 + 1] = cim[g * 1024 + idx]; }
    __syncthreads();
    for (int idx = F.tid; idx < 64 * 16; idx += 512) { const int p = idx >> 4, c = idx & 15;
        const float lr = lre[g * 64 + p], li = lim[g * 64 + p], ar = AP[(64 + p) * 2], ai = AP[(64 + p) * 2 + 1];
        const float den = lr * lr + li * li, zr = ((ar - 1.f) * lr + ai * li) / den, zi = (ai * lr - (ar - 1.f) * li) / den;
        const float br = bre[(g * 64 + p) * 16 + c], bi = bim[(g * 64 + p) * 16 + c];
        BB[idx * 2] = zr * br - zi * bi; BB[idx * 2 + 1] = zr * bi + zi * br; }
    __syncthreads();
    constexpr int KP = 132;
    { const int j = F.tid >> 4, cl = (F.tid >> 2) & 3, c = 4 * qtr + cl, c2q = F.tid & 3; float acc[4] = {0.f, 0.f, 0.f, 0.f};
#pragma unroll 8
        for (int p = 0; p < 64; ++p) { const f32x2 cc = *(const LAS f32x2*)(CL + (c * 64 + p) * 2), aa = *(const LAS f32x2*)(AP + (j * 64 + p) * 2);
            const float car = cc.x * aa.x - cc.y * aa.y, cai = cc.x * aa.y + cc.y * aa.x;
#pragma unroll
            for (int e = 0; e < 4; ++e) { const f32x2 bb = *(const LAS f32x2*)(BB + (p * 16 + 4 * c2q + e) * 2); acc[e] += car * bb.x - cai * bb.y; } }
#pragma unroll
        for (int e = 0; e < 4; ++e) { if (j == 0 && c == 4 * c2q + e) acc[e] += dsk[g * 16 + c]; KT[(4 * c2q + e) * KP + cl * 32 + j] = acc[e]; } }
    __syncthreads();
    for (int o = F.tid; o < 128 * 64; o += 512) { const int nl = o >> 6, ko = o & 63, i = nl >> 2, cl = nl & 3, c = 4 * qtr + cl, n = i * 16 + c, sft = ko >> 1, c20 = (ko & 1) * 8; float v[8];
#pragma unroll
        for (int q = 0; q < 8; ++q) { const int jj = (sft <= i) ? i - sft : 0; const float t = KT[(c20 + q) * KP + cl * 32 + jj]; v[q] = (sft <= i) ? t : 0.f; }
        u32x4 w; w.x = cvtpk(v[0], v[1]); w.y = cvtpk(v[2], v[3]); w.z = cvtpk(v[4], v[5]); w.w = cvtpk(v[6], v[7]);
        *(u32x4*)(BTY + ((size_t)(g * 512 + n) * 640 + ko * 8)) = w; }
    for (int o = F.tid; o < 128 * 16; o += 512) { const int nl = o >> 4, kc = o & 15, i = nl >> 2, cl = nl & 3, c = 4 * qtr + cl, n = i * 16 + c; float v[8];
#pragma unroll
        for (int q = 0; q < 8; ++q) { const int pp = kc * 8 + q, p = pp & 63; const float cr = CL[(c * 64 + p) * 2], ci = CL[(c * 64 + p) * 2 + 1];
            const float ar = AP[((i + 1) * 64 + p) * 2], ai = AP[((i + 1) * 64 + p) * 2 + 1];
            v[q] = (pp < 64) ? (cr * ar - ci * ai) : -(cr * ai + ci * ar); }
        u32x4 w; w.x = cvtpk(v[0], v[1]); w.y = cvtpk(v[2], v[3]); w.z = cvtpk(v[4], v[5]); w.w = cvtpk(v[6], v[7]);
        *(u32x4*)(BTY + ((size_t)(g * 512 + n) * 640 + (64 + kc) * 8)) = w; }
    for (int o = F.tid; o < 64 * 64; o += 512) { const int pp = 64 * qtr + (o >> 6), ko = o & 63, s = ko >> 1, c20 = (ko & 1) * 8, p = pp & 63; float v[8];
#pragma unroll
        for (int q = 0; q < 8; ++q) { const float ar = AP[((31 - s) * 64 + p) * 2], ai = AP[((31 - s) * 64 + p) * 2 + 1], br = BB[(p * 16 + c20 + q) * 2], bi = BB[(p * 16 + c20 + q) * 2 + 1];
            v[q] = (pp < 64) ? (ar * br - ai * bi) : ((pp < 128) ? (ar * bi + ai * br) : 0.f); }
        u32x4 w; w.x = cvtpk(v[0], v[1]); w.y = cvtpk(v[2], v[3]); w.z = cvtpk(v[4], v[5]); w.w = cvtpk(v[6], v[7]);
        *(u32x4*)(BTS + ((size_t)(g * 256 + pp) * 512 + ko * 8)) = w; }
    if (qtr == 0 && F.tid < 64) { APOW[(g * 64 + F.tid) * 2] = AP[(32 * 64 + F.tid) * 2]; APOW[(g * 64 + F.tid) * 2 + 1] = AP[(32 * 64 + F.tid) * 2 + 1]; }
    __syncthreads();
}

__device__ __forceinline__ void phase_p0a(const Frame& F, const Args& a) {
    const bool split = F.G >= 256;
    LAS float* scr = (LAS float*)(F.lds + RING_OFF + F.wave * 8704);
    bf16_t* Wabin = (bf16_t*)(a.ws + WS_W_ABIN); bf16_t* Wabout = (bf16_t*)(a.ws + WS_W_ABOUT); bf16_t* Wglu = (bf16_t*)(a.ws + WS_W_GLU); bf16_t* Wpool = (bf16_t*)(a.ws + WS_W_POOL);
    auto wcopy = [&](int it) {
        if (it < 512) transpose_full(a.in[I_ABIN], 1024, 1024, Wabin, it, scr, F.lane);
        else if (it < 1024) transpose_full(a.in[I_ABOUT], 1024, 1024, Wabout, it - 512, scr, F.lane);
        else transpose_full(a.in[I_GLUW], 512, 512, Wglu, it - 1024, scr, F.lane); };
    constexpr int NCOPY = 512 + 512 + 128, NCOPY_A = 576;
    if (!split || F.vcu < 128) { for (int it = F.vcu; it < 128; it += F.G) s5_tables(F, a, it >> 2, it & 3);
        if (split) { for (int it = NCOPY_A + F.vcu * NWAVES + F.wave; it < NCOPY; it += 128 * NWAVES) wcopy(it); return; } }
    const int gw = (split ? F.vcu - 128 : F.vcu) * NWAVES + F.wave, NGW = (split ? F.G - 128 : F.G) * NWAVES;
    const float* cvec = a.in[I_C]; const float* adaw = a.in[I_ADAW]; float* MODP = (float*)(a.ws + WS_MODP);
    for (int task = gw; task < 4 * 6 * NKS; task += NGW) { const int ks = task % NKS, c6 = (task / NKS) % 6, is = task / (NKS * 6);
        const float* W = adaw + (size_t)is * 1024 * 3072 + c6 * 512 + F.lane * 4; f32x4 acc[4][2];
#pragma unroll
        for (int b = 0; b < 4; ++b) { acc[b][0] = (f32x4){0.f, 0.f, 0.f, 0.f}; acc[b][1] = (f32x4){0.f, 0.f, 0.f, 0.f}; }
        const int kper = 1024 / NKS;
#pragma unroll 8
        for (int k = ks * kper; k < ks * kper + kper; ++k) { const f32x4 w0 = *(const f32x4*)(W + (size_t)k * 3072), w1 = *(const f32x4*)(W + (size_t)k * 3072 + 256);
#pragma unroll
            for (int b = 0; b < 4; ++b) { const float cb = cvec[b * 1024 + k]; acc[b][0] += cb * w0; acc[b][1] += cb * w1; } }
#pragma unroll
        for (int b = 0; b < 4; ++b) { float* o = MODP + ((size_t)((ks * 4 + is) * 4 + b)) * 3072 + c6 * 512 + F.lane * 4; *(f32x4*)o = acc[b][0]; *(f32x4*)(o + 256) = acc[b][1]; } }
    for (int it = gw; it < (split ? NCOPY_A : NCOPY); it += NGW) wcopy(it);
    const float* pw = a.in[I_POOLW];
    for (int idx = gw * 64 + F.lane; idx < 512 * 256; idx += NGW * 64) { const int n = idx >> 8, kk = idx & 255, g = n >> 7, co = n & 127, half = kk >> 7, ci = kk & 127;
        const float v = (half == (g & 1)) ? pw[((size_t)g * 128 + ci) * 128 + co] : 0.f; Wpool[idx] = (bf16_t)(cvtpk(v, 0.f) & 0xffffu); }
}

template <bool FROM_PARTIALS> __device__ __forceinline__ void norm_mod_rows(const Frame& F, const Args& a, const float* xin, int is, bf16_t* H) {
    LAS float* gs = (LAS float*)(F.lds); LAS float* sh = gs + 1024;
    const float* MODP = (const float*)(a.ws + WS_MODP); const float* MODF = (const float*)(a.ws + WS_MODF); const float* ng = a.in[I_NORMG] + is * 1024; const float* ab = a.in[I_ADAB] + is * 3072;
    for (int rb = F.vcu; rb < MTOK / 64; rb += F.G) { const int b = rb >> 6;
        __syncthreads();
        for (int c = F.tid; c < 1024; c += 512) { float shift, scale;
            if (FROM_PARTIALS) { shift = ab[c]; scale = ab[1024 + c];
#pragma unroll
                for (int ks = 0; ks < NKS; ++ks) { const float* m = MODP + ((size_t)((ks * 4 + is) * 4 + b)) * 3072; shift += m[c]; scale += m[1024 + c]; } }
            else { const float* m = MODF + (size_t)(is * 4 + b) * 3072; shift = m[c]; scale = m[1024 + c]; }
            gs[c] = ng[c] * (1.f + scale); sh[c] = shift; }
        __syncthreads();
        for (int r0 = F.wave * 8; r0 < F.wave * 8 + 8; r0 += 4) {
            f32x4 v[4][4]; float s[4];
#pragma unroll
            for (int q = 0; q < 4; ++q) { const f32x4* xr = (const f32x4*)(xin + ((size_t)rb * 64 + r0 + q) * 1024) + F.lane;
#pragma unroll
                for (int j = 0; j < 4; ++j) v[q][j] = xr[64 * j]; }
#pragma unroll
            for (int q = 0; q < 4; ++q) { s[q] = 0.f;
#pragma unroll
                for (int j = 0; j < 4; ++j) s[q] += (v[q][j].x * v[q][j].x + v[q][j].y * v[q][j].y) + (v[q][j].z * v[q][j].z + v[q][j].w * v[q][j].w); }
#pragma unroll
            for (int o = 1; o < 64; o <<= 1) {
#pragma unroll
                for (int q = 0; q < 4; ++q) s[q] += __shfl_xor(s[q], o); }
#pragma unroll
            for (int q = 0; q < 4; ++q) { const float rstd = 1.f / sqrtf(s[q] * (1.f / 1024.f) + EPS); u32x2* o8 = (u32x2*)(H + ((size_t)rb * 64 + r0 + q) * 1024) + F.lane;
#pragma unroll
                for (int j = 0; j < 4; ++j) { const int c0 = 4 * F.lane + 256 * j; const f32x4 g4 = *(const LAS f32x4*)(gs + c0), s4 = *(const LAS f32x4*)(sh + c0);
                    const f32x4 y = v[q][j] * rstd * g4 + s4; u32x2 w; w.x = cvtpk(y.x, y.y); w.y = cvtpk(y.z, y.w); o8[64 * j] = w; } } }
    }
    __syncthreads();
}

__device__ __forceinline__ void phase_p0b(const Frame& F, const Args& a) {
    { const float* MODP = (const float*)(a.ws + WS_MODP); float* MODF = (float*)(a.ws + WS_MODF); const float* ab = a.in[I_ADAB];
      for (int idx = F.vcu * 512 + F.tid; idx < 16 * 3072; idx += F.G * 512) { const int n = idx % 3072, isb = idx / 3072, is = isb >> 2, b = isb & 3; float s = ab[is * 3072 + n];
#pragma unroll
          for (int ks = 0; ks < NKS; ++ks) s += MODP[((size_t)((ks * 4 + is) * 4 + b)) * 3072 + n];
          MODF[idx] = s; } }
    { const float* MODP = (const float*)(a.ws + WS_MODP); float* GS = (float*)(a.ws + WS_GS); const float* ab = a.in[I_ADAB]; const float* ng = a.in[I_NORMG];
      for (int idx = F.vcu * 512 + F.tid; idx < 4 * 4 * 1024; idx += F.G * 512) { const int c = idx & 1023, b = (idx >> 10) & 3, is = (idx >> 12) + 1;
          if (is == 4) { GS[idx] = a.in[I_FING][c]; continue; }
          float sc = ab[is * 3072 + 1024 + c];
#pragma unroll
          for (int ks = 0; ks < NKS; ++ks) sc += MODP[((size_t)((ks * 4 + is) * 4 + b)) * 3072 + 1024 + c];
          GS[idx] = ng[is * 1024 + c] * (1.f + sc); } }
    norm_mod_rows<true>(F, a, a.in[I_X], 0, (bf16_t*)(a.ws + WS_H));
}

__device__ __forceinline__ void stage_shift3(const Frame& F, const float* MF, LAS bf16_t* shl) {
    __syncthreads();
    for (int idx = F.tid; idx < 3 * 4 * 1024 / 2; idx += 512) { const int ub = idx >> 9, c = (idx & 511) * 2; const float* sp = MF + (size_t)(4 + ub) * 3072 + c; *(LAS unsigned*)(shl + ub * 1024 + c) = cvtpk(sp[0], sp[1]); }
    __syncthreads();
}
__device__ __forceinline__ void sw_block(const Frame& F, const bf16_t* Wt, int N, int blk, const LAS bf16_t* shl, float* SW) {
    const int r = F.lane & 15, kq = F.lane >> 4; const bf16_t* wp = Wt + (size_t)(blk * 16 + r) * 1024 + 8 * kq; f32x4 acc = (f32x4){0.f, 0.f, 0.f, 0.f};
    bf16x8 wf[32];
#pragma unroll
    for (int j = 0; j < 32; ++j) wf[j] = *(const bf16x8*)(wp + 32 * j);
#pragma unroll
    for (int j = 0; j < 32; ++j) { bf16x8 sf = *(const LAS bf16x8*)(shl + (r & 3) * 1024 + 32 * j + 8 * kq); if (r >= 4) sf = (bf16x8){0, 0, 0, 0, 0, 0, 0, 0};
        acc = __builtin_amdgcn_mfma_f32_16x16x32_bf16(sf, wf[j], acc, 0, 0, 0); }
    if (kq == 0) {
#pragma unroll
        for (int b = 0; b < 4; ++b) SW[(size_t)b * N + blk * 16 + r] = acc[b]; }
}

__device__ __forceinline__ void convert_late(const Frame& F, const Args& a, int part, int wv, int nwv, LAS float* scr) {
    bf16_t* W1 = (bf16_t*)(a.ws + WS_W1); bf16_t* W2 = (bf16_t*)(a.ws + WS_W2); bf16_t* Wcdin = (bf16_t*)(a.ws + WS_W_CDIN); bf16_t* Wcdout = (bf16_t*)(a.ws + WS_W_CDOUT);
    constexpr int NSEG = 9;
    const int seg_src[NSEG] = {0, 512, 1024, 1536, 2048, 2112, 2120, 2632, 3144}, seg_w[NSEG] = {512, 512, 512, 512, 64, 8, 512, 512, 512}, seg_dst[NSEG] = {PC_QC, PC_KC, PC_VC, PC_QI, PC_KI, PC_WI, PC_QD, PC_KD, PC_VD};
    constexpr int I_MLP = 2048, I_CDI = 16 * 115  , I_CDO = 512, NIT = 4 * I_MLP + I_CDI + I_CDO;
    const int lo = part == 0 ? 0 : (part == 1 ? 1500 : 6000), hi = part == 0 ? 1500 : (part == 1 ? 6000 : NIT);
    for (int it = lo + wv; it < hi; it += nwv) { int r = it;
        if (r < I_MLP) { transpose_full(a.in[I_W1], 1024, 4096, W1, r, scr, F.lane); continue; } r -= I_MLP;
        if (r < I_MLP) { transpose_full(a.in[I_W2], 4096, 1024, W2, r, scr, F.lane); continue; } r -= I_MLP;
        if (r < I_CDI) { const int kb = r / 115; int nb = r % 115, sg = 0;
#pragma unroll
            for (int q = 0; q < NSEG; ++q) { const int nbq = (seg_w[q] + 31) / 32; if (sg == q && nb >= nbq) { nb -= nbq; sg = q + 1; } }
            const int wdt = seg_w[sg] - 32 * nb < 32 ? seg_w[sg] - 32 * nb : 32;
            transpose_item(a.in[I_CDIN], 3656, seg_src[sg] + 32 * nb, wdt, 64 * kb, Wcdin, 1024, seg_dst[sg] + 32 * nb, scr, F.lane); continue; } r -= I_CDI;
        if (r < I_CDO) { transpose_full(a.in[I_CDOUT], 1024, 1024, Wcdout, r, scr, F.lane); continue; } r -= I_CDO;
        if (r < I_MLP) { transpose_full(a.in[I_W1] + (size_t)1024 * 4096, 1024, 4096, W1 + (size_t)4096 * 1024, r, scr, F.lane); continue; } r -= I_MLP;
        transpose_full(a.in[I_W2] + (size_t)4096 * 1024, 4096, 1024, W2 + (size_t)1024 * 4096, r, scr, F.lane);
    }
    if (part == 2)
        for (int idx = wv * 64 + F.lane; idx < (PW - 3656) * 1024 / 8; idx += nwv * 64) *(u32x4*)(Wcdin + (size_t)3656 * 1024 + (size_t)idx * 8) = (u32x4){0u, 0u, 0u, 0u};
}

template <int WIN> __device__ __forceinline__ void pool_ld(u32x4 (&w)[WIN], const bf16_t* V, int row, int ch0) {
    const bf16_t* p = V + (size_t)row * 512 + ch0;
#pragma unroll
    for (int j = 0; j < WIN; ++j) w[j] = *(const u32x4*)(p - j * 512);
}
template <int WIN> __device__ __forceinline__ void pool_fin(const u32x4 (&w)[WIN], bf16_t* CAT, const float* scale, int row, int ch0) {
    const int t = row & 4095;
    float s[8];
#pragma unroll
    for (int q = 0; q < 8; ++q) s[q] = 0.f;
#pragma unroll
    for (int j = 0; j < WIN; ++j) { const bool in = (j <= t);
#pragma unroll
        for (int q = 0; q < 4; ++q) { s[2 * q] += in ? __uint_as_float(w[j][q] << 16) : 0.f; s[2 * q + 1] += in ? __uint_as_float(w[j][q] & 0xffff0000u) : 0.f; } }
    const float inv = 1.f / (float)((t + 1 < WIN) ? t + 1 : WIN); u32x4 o; const f32x4 sc0 = *(const f32x4*)(scale + ch0), sc1 = *(const f32x4*)(scale + ch0 + 4);
    float u0[8];
#pragma unroll
    for (int q = 0; q < 4; ++q) { u0[2 * q] = __uint_as_float(w[0][q] << 16); u0[2 * q + 1] = __uint_as_float(w[0][q] & 0xffff0000u); }
    o[0] = cvtpk((s[0] * inv - u0[0]) * sc0.x, (s[1] * inv - u0[1]) * sc0.y); o[1] = cvtpk((s[2] * inv - u0[2]) * sc0.z, (s[3] * inv - u0[3]) * sc0.w);
    o[2] = cvtpk((s[4] * inv - u0[4]) * sc1.x, (s[5] * inv - u0[5]) * sc1.y); o[3] = cvtpk((s[6] * inv - u0[6]) * sc1.z, (s[7] * inv - u0[7]) * sc1.w);
    *(u32x4*)(CAT + (size_t)row * 1024 + ch0) = o;
}
__device__ __forceinline__ void pool_post(const Frame& F, const Args& a, int wgi, int nwg) {
    const bf16_t* V = (const bf16_t*)(a.ws + WS_PA); bf16_t* CAT = (bf16_t*)(a.ws + WS_CAT); const float* scale = a.in[I_POOLS];
    for (int rq = wgi * NWAVES + F.wave; rq < MTOK / 4; rq += nwg * NWAVES) { const int row = rq * 4 + (F.lane >> 4), c8 = (F.lane & 15) * 8;
        u32x4 w2[2], w4[4], w8[8], w16[16];
        pool_ld<2>(w2, V, row, c8); pool_ld<4>(w4, V, row, 128 + c8); pool_ld<8>(w8, V, row, 256 + c8); pool_ld<16>(w16, V, row, 384 + c8);
        pool_fin<2>(w2, CAT, scale, row, c8); pool_fin<4>(w4, CAT, scale, row, 128 + c8); pool_fin<8>(w8, CAT, scale, row, 256 + c8); pool_fin<16>(w16, CAT, scale, row, 384 + c8); }
}

__device__ __forceinline__ void s5_recurrence(const Frame& F, const Args& a, int gwv) {
    if (gwv >= 128) return;
    const int b = gwv >> 5, g = gwv & 31, p = F.lane;
    const float* SST = (const float*)(a.ws + WS_SST); const float* APOW = (const float*)(a.ws + WS_APOW); bf16_t* UEXT = (bf16_t*)(a.ws + WS_UEXT);
    const float ar = APOW[(g * 64 + p) * 2], ai = APOW[(g * 64 + p) * 2 + 1];
    float hr = 0.f, hi = 0.f;
    const size_t row0 = (size_t)g * 512 + b * 128;
    for (int k0 = 0; k0 < 128; k0 += 16) { float sr[16], si[16];
#pragma unroll
        for (int j = 0; j < 16; ++j) { sr[j] = SST[(row0 + k0 + j) * 128 + p]; si[j] = SST[(row0 + k0 + j) * 128 + 64 + p]; }
#pragma unroll
        for (int j = 0; j < 16; ++j) { bf16_t* o = UEXT + (row0 + k0 + j) * 640 + 512 + p;
            const unsigned w = cvtpk(hr, hi); o[0] = (bf16_t)(w & 0xffffu); o[64] = (bf16_t)(w >> 16);
            const float nr = ar * hr - ai * hi + sr[j], ni = ar * hi + ai * hr + si[j]; hr = nr; hi = ni; } }
}

__device__ __forceinline__ unsigned sortable(float f) { const unsigned u = __float_as_uint(f); return (u & 0x80000000u) ? ~u : (u | 0x80000000u); }
__device__ __forceinline__ void idx_unit(const Frame& F, const Args& a, int b, int qt) {
    int tid = F.tid; asm volatile("" : "+v"(tid)); const int lane = tid & 63, w = F.wave, qq = lane & 15, g4 = lane >> 4;
    const int q0 = qt * 16, ntile = 4 * ((q0 >> 6) + 1);
    const bf16_t* P = (const bf16_t*)(a.ws + WS_PROJ) + (size_t)b * SEQ * PW;
    const float* WI = (const float*)(a.ws + WS_WIF) + ((size_t)b * SEQ + q0 + qq) * 8;
    LAS bf16_t* qil = (LAS bf16_t*)(F.lds);
#pragma unroll
    for (int e = 0; e < 2; ++e) { const int idx = tid + 512 * e, row = idx >> 6, seg = idx & 63;
        *(LAS u32x4*)(qil + row * 520 + seg * 8) = *(const u32x4*)(P + (size_t)(q0 + row) * PW + PC_QI + seg * 8); }
    float wh[8];
    { const f32x4 w0 = *(const f32x4*)WI, w1 = *(const f32x4*)(WI + 4); wh[0] = w0.x; wh[1] = w0.y; wh[2] = w0.z; wh[3] = w0.w; wh[4] = w1.x; wh[5] = w1.y; wh[6] = w1.z; wh[7] = w1.w; }
    __syncthreads();
    const int nj = (ntile - w + 7) >> 3;
    unsigned sc[32][4];
    constexpr int TG = 2;
#pragma unroll
    for (int jj = 0; jj < 32 / TG; ++jj) {
        if (TG * jj < nj) {
            bf16x8 kf[TG][2];
#pragma unroll
            for (int u = 0; u < TG; ++u) { int kt = 8 * (TG * jj + u) + w; kt = kt < ntile ? kt : ntile - 1; const bf16_t* kp = P + (size_t)(16 * kt + qq) * PW + PC_KI + 8 * g4;
                kf[u][0] = *(const bf16x8*)kp; kf[u][1] = *(const bf16x8*)(kp + 32); }
            f32x4 s4[TG];
#pragma unroll
            for (int u = 0; u < TG; ++u) s4[u] = (f32x4){0.f, 0.f, 0.f, 0.f};
#pragma unroll
            for (int h = 0; h < 8; ++h) { int qoff = qq * 520 + 8 * g4; asm volatile("" : "+v"(qoff));
                const bf16x8 qa = *(const LAS bf16x8*)(qil + qoff + h * 64), qb = *(const LAS bf16x8*)(qil + qoff + h * 64 + 32);
#pragma unroll
                for (int u = 0; u < TG; ++u) { f32x4 acc = __builtin_amdgcn_mfma_f32_16x16x32_bf16(kf[u][0], qa, (f32x4){0.f, 0.f, 0.f, 0.f}, 0, 0, 0);
                    acc = __builtin_amdgcn_mfma_f32_16x16x32_bf16(kf[u][1], qb, acc, 0, 0, 0);
#pragma unroll
                    for (int i = 0; i < 4; ++i) s4[u][i] = __builtin_fmaf(fmaxf(acc[i], 0.f), wh[h], s4[u][i]); }
                __builtin_amdgcn_sched_barrier(0); }
#pragma unroll
            for (int u = 0; u < TG; ++u) { const bool ok = (8 * (TG * jj + u) + w) < ntile;
#pragma unroll
                for (int i = 0; i < 4; ++i) sc[TG * jj + u][i] = ok ? sortable(s4[u][i]) : 0u; }
        } else {
#pragma unroll
            for (int u = 0; u < TG; ++u)
#pragma unroll
                for (int i = 0; i < 4; ++i) sc[TG * jj + u][i] = 0u;
        }
    }
    __syncthreads();
    const int nc = ntile >> 2;
    unsigned long long* MASK64 = (unsigned long long*)(a.ws + WS_MASK) + ((size_t)b * SEQ + q0) * 64;
#pragma unroll 1
    for (int hh = 0; hh < 2; ++hh) {
        if ((qq >> 3) == hh) { const int q3 = qq & 7;
            LAS unsigned char* wb = F.lds + q3 * 16384 + (((4 * w + g4) ^ q3) << 4);
#pragma unroll
            for (int j = 0; j < 32; ++j) *(LAS u32x4*)(wb + 512 * j) = (u32x4){sc[j][0], sc[j][1], sc[j][2], sc[j][3]}; }
        __syncthreads();
        unsigned kq[64]; const LAS unsigned char* rb = F.lds + w * 16384 + ((((lane >> 2) ^ w)) << 4) + ((lane & 3) << 2);
#pragma unroll
        for (int cg = 0; cg < 8; ++cg) {
            if (8 * cg < nc) {
#pragma unroll
                for (int c8 = 0; c8 < 8; ++c8) { const int c = 8 * cg + c8; kq[c] = *(const LAS unsigned*)(rb + 256 * c); }
            } else {
#pragma unroll
                for (int c8 = 0; c8 < 8; ++c8) kq[8 * cg + c8] = 0u;
            } }
        __syncthreads();
#define IDX_CNT4(dst, candv, k0, k1, k2, k3) do { unsigned long long m0_, m1_, m2_, m3_; unsigned t0_, t1_, t2_, t3_; \
            asm volatile("v_cmp_le_u32_e64 %1, %9, %10\n\tv_cmp_le_u32_e64 %2, %9, %11\n\tv_cmp_le_u32_e64 %3, %9, %12\n\tv_cmp_le_u32_e64 %4, %9, %13\n\t" \
                         "s_bcnt1_i32_b64 %5, %1\n\ts_bcnt1_i32_b64 %6, %2\n\ts_bcnt1_i32_b64 %7, %3\n\ts_bcnt1_i32_b64 %8, %4\n\t" \
                         "s_add_u32 %0, %0, %5\n\ts_add_u32 %0, %0, %6\n\ts_add_u32 %0, %0, %7\n\ts_add_u32 %0, %0, %8" \
                         : "+s"(dst), "=&s"(m0_), "=&s"(m1_), "=&s"(m2_), "=&s"(m3_), "=&s"(t0_), "=&s"(t1_), "=&s"(t2_), "=&s"(t3_) \
                         : "s"(candv), "v"(k0), "v"(k1), "v"(k2), "v"(k3) : "scc"); } while (0)
#define IDX_COUNT(dst, candv) do { dst = 0u; _Pragma("unroll") for (int cg = 0; cg < 8; ++cg) if (8 * cg < nc) { \
            IDX_CNT4(dst, candv, kq[8 * cg], kq[8 * cg + 1], kq[8 * cg + 2], kq[8 * cg + 3]); IDX_CNT4(dst, candv, kq[8 * cg + 4], kq[8 * cg + 5], kq[8 * cg + 6], kq[8 * cg + 7]); } } while (0)
        unsigned T = 1u, need = 0u; bool tie = false;
        if (nc * 64 > 256) {
            unsigned kmax = 0u, km1 = 0xffffffffu;
#pragma unroll
            for (int c = 0; c < 64; ++c) { kmax = kq[c] > kmax ? kq[c] : kmax; km1 = (kq[c] - 1u < km1) ? kq[c] - 1u : km1; }
#pragma unroll
            for (int o = 1; o < 64; o <<= 1) { const unsigned t = (unsigned)__shfl_xor((int)kmax, o), t2 = (unsigned)__shfl_xor((int)km1, o); kmax = t > kmax ? t : kmax; km1 = t2 < km1 ? t2 : km1; }
            kmax = (unsigned)__builtin_amdgcn_readfirstlane((int)kmax); km1 = (unsigned)__builtin_amdgcn_readfirstlane((int)km1);
            unsigned lo = km1 + 1u, hi = kmax + 1u, clo = (unsigned)(nc * 64), chi = 0u; bool triedz = false;
            for (int it = 0; it < 72; ++it) {
                if (clo == 256u || hi - lo <= 1u) break;
                unsigned cand;
                if (lo < 0x80000000u && hi > 0x80000000u) cand = 0x80000000u;
                else if (lo == 0x80000000u && !triedz) { cand = 0x80000001u; triedz = true; }
                else { const unsigned ul = (lo & 0x80000000u) ? (lo ^ 0x80000000u) : ~lo, uh = (hi & 0x80000000u) ? (hi ^ 0x80000000u) : ~hi;
                    cand = sortable(0.5f * (__uint_as_float(ul) + __uint_as_float(uh)));
                    if (it >= 26 || cand <= lo || cand >= hi) cand = lo + ((hi - lo) >> 1); }
                cand = cand > lo ? cand : lo + 1u; cand = cand < hi ? cand : hi - 1u;
                unsigned cnt; IDX_COUNT(cnt, cand);
                if (cnt >= 256u) { lo = cand; clo = cnt; } else { hi = cand; chi = cnt; }
            }
            T = lo; tie = clo > 256u; need = 256u - chi;
        }
        unsigned long long myword = 0ull; int lane_o = lane; asm volatile("" : "+v"(lane_o));
        if (!tie) {
#pragma unroll
            for (int cg = 0; cg < 8; ++cg) if (8 * cg < nc) {
#pragma unroll
                for (int c8 = 0; c8 < 8; ++c8) { const int c = 8 * cg + c8; const unsigned long long wsel = __builtin_amdgcn_ballot_w64(kq[c] >= T); if (lane_o == c) myword = wsel; } }
        } else {
#pragma unroll 1
            for (int c = 0; c < nc; ++c) { unsigned k_ = 0u;
#pragma unroll
                for (int cc = 0; cc < 64; ++cc) k_ = (cc == c) ? kq[cc] : k_;
                unsigned long long wsel = __builtin_amdgcn_ballot_w64(k_ > T), eq = __builtin_amdgcn_ballot_w64(k_ == T);
                const unsigned t = (unsigned)__builtin_popcountll(eq);
                if (t <= need) { wsel |= eq; need -= t; }
                else { while (need) { const unsigned long long lowbit = eq & (0ull - eq); wsel |= lowbit; eq ^= lowbit; --need; } }
                if (lane_o == c) myword = wsel; }
        }
        MASK64[(size_t)(8 * hh + w) * 64 + lane] = myword;
#undef IDX_COUNT
#undef IDX_CNT4
    }
}

__global__ void __launch_bounds__(NWAVES * 64, 2) mk_fwd(Args args_unused) {
    extern __shared__ __attribute__((aligned(16))) unsigned char lds[];
    Frame F;
    F.lds = (LAS unsigned char*)lds;
    F.tid = threadIdx.x; F.lane = F.tid & 63; F.wave = __builtin_amdgcn_readfirstlane(F.tid >> 6);
    F.G = gridDim.x; { const int bx = blockIdx.x; F.vcu = (F.G % 8 == 0) ? (bx % 8) * (F.G / 8) + bx / 8 : bx; }
    typedef const Args __attribute__((address_space(4))) * kargp_t;
    const kargp_t ap = (kargp_t)__builtin_amdgcn_kernarg_segment_ptr();
#define PHASE_ARGS() kargp_t ap_ = ap; asm volatile("" : "+s"(ap_)); Args a; __builtin_memcpy(&a, (const void __attribute__((address_space(4)))*)ap_, sizeof(Args)); unsigned char* const ws = a.ws; (void)ws
    volatile LAS unsigned* MISC = (volatile LAS unsigned*)(F.lds + MISC_OFF);
    for (int u = F.tid; u < (LDS_BYTES - LDSCTL_OFF) / 4; u += NWAVES * 64) ((LAS unsigned*)(F.lds + LDSCTL_OFF))[u] = 0u;
    __syncthreads();
    XcdBarrier bar; bar.bar = nullptr; bar.x = 0; bar.st = nullptr;
#if !MK_PER_PHASE
    { PHASE_ARGS(); bar = xcd_barrier_post((unsigned*)(ws + WS_CTL) + CW_BAR, MISC + 8); }
#define GRID_BAR() xcd_barrier(bar)
#else
#define GRID_BAR() do {} while (0)
#endif
    int lo, hi; { PHASE_ARGS(); lo = a.ph_lo; hi = a.ph_hi; }
#ifndef PH_MASK
#define PH_MASK 0xFFFFFu
#endif
#define IN(k) ((((PH_MASK) >> (k)) & 1u) && lo <= (k) && (k) < hi)
#ifndef PROBE_DUP
#define PROBE_DUP 0u
#endif
#define NREP(k) ((((PROBE_DUP) >> (k)) & 1u) ? 2 : 1)
#define SEAM(k) do { if (IN(k) && IN((k) + 1)) GRID_BAR(); } while (0)
#define PHASE_1(k) if (IN(k))
#define PHASE_2(k) for (int rep_ = 0; rep_ < 2; ++rep_) if (IN(k))
#define PHASE_SEL(k, n) PHASE_##n(k)
#define PHASE(k) if (IN(k)) for (int rep_ = 0; rep_ < NREP(k); ++rep_)
    const int bx = (int)blockIdx.x;
    using namespace pg8;
#define WSP(T, off) ((T*)(ws + (off)))
#define MODF_GATE(is) (WSP(const float, WS_MODF) + (is) * 4 * 3072 + 2048)

    PHASE(0) { PHASE_ARGS(); phase_p0a(F, a); } SEAM(0);
    PHASE(1) { PHASE_ARGS(); phase_p0b(F, a); } SEAM(1);
    PHASE(2) { PHASE_ARGS(); Gemm g{WSP(bf16_t, WS_H), WSP(const bf16_t, WS_W_ABIN), 1024, 1024, 1024}; Sched<SM_STD> S; S.init(64, 4, F.G, bx);
        EpiInAB E{WSP(bf16_t, WS_UA), WSP(bf16_t, WS_UEXT)}; gemm_phase<EpiInAB, Sched<SM_STD>, true>(F.lds + RING_OFF, g, S, E); } SEAM(2);
    PHASE(3) { PHASE_ARGS();
        LAS float* scr = (LAS float*)(F.lds + RING_OFF + F.wave * 8704);
        if (F.G >= 256) {
            if (bx < 64) { Gemm g{WSP(const bf16_t, WS_UEXT), WSP(const bf16_t, WS_BTS), 640, 512, 512}; Sched<SM_S5S> S; S.init(64, 1, 64, bx);
                EpiStateF32 E{WSP(float, WS_SST)}; gemm_phase<EpiStateF32, Sched<SM_S5S>, true>(F.lds + RING_OFF, g, S, E);
                if (F.wave < 2) { __builtin_amdgcn_fence(__ATOMIC_ACQUIRE, "agent"); s5_recurrence(F, a, (2 * (bx & 1) + F.wave) * 32 + (bx >> 1)); } }
            else if (bx < 192) { Gemm g{WSP(const bf16_t, WS_UA), WSP(const bf16_t, WS_W_POOL), 512, 256, 256}; Sched<SM_POOL> S; S.init(64, 2, 128, bx - 64);
                EpiBf16Plain E{WSP(bf16_t, WS_PA), 512}; gemm_phase<EpiBf16Plain, Sched<SM_POOL>, true>(F.lds + RING_OFF, g, S, E); }
            else convert_late(F, a, 0, (bx - 192) * 8 + F.wave, (F.G - 192) * 8, scr);
        } else {
        }
    } SEAM(3);
    PHASE(4) { PHASE_ARGS();
        Gemm g{WSP(const bf16_t, WS_UEXT), WSP(const bf16_t, WS_BTY), 640, 640, 640}; Sched<SM_S5Y> S; S.init(64, 2, F.G, bx);
        EpiYGelu E{WSP(bf16_t, WS_YB)}; gemm_phase<EpiYGelu, Sched<SM_S5Y>, true>(F.lds + RING_OFF, g, S, E);
        if (bx >= 128) { LAS float* scr = (LAS float*)(F.lds + RING_OFF + F.wave * 8704); pool_post(F, a, bx - 128, F.G - 128); convert_late(F, a, 1, (bx - 128) * 8 + F.wave, (F.G - 128) * 8, scr); }
    } SEAM(4);
    PHASE(6) { PHASE_ARGS(); Gemm g{WSP(const bf16_t, WS_YB), WSP(const bf16_t, WS_W_GLU), 512, 512, 512}; Sched<SM_STD> S; S.init(64, 2, F.G, bx);
        EpiGlu E{WSP(bf16_t, WS_CAT), WSP(const bf16_t, WS_YB), a.in[I_GLUB]}; gemm_phase<EpiGlu, Sched<SM_STD>, true>(F.lds + RING_OFF, g, S, E);
        if (bx >= 128) { LAS float* scr = (LAS float*)(F.lds + RING_OFF + F.wave * 8704); convert_late(F, a, 2, (bx - 128) * 8 + F.wave, (F.G - 128) * 8, scr); } } SEAM(6);
    PHASE(7) { PHASE_ARGS(); Gemm g{WSP(bf16_t, WS_CAT), WSP(const bf16_t, WS_W_ABOUT), 1024, 1024, 1024}; Sched<SM_STD> S; S.init(64, 4, F.G, bx);
        EpiResidNorm<true> E{a.in[I_X], nullptr, (bf16_t*)ws, MODF_GATE(0), WSP(const float, WS_GS), WSP(bf16_t, WS_H), WSP(float, WS_SSQ)}; gemm_phase<EpiResidNorm<true>, Sched<SM_STD>, true>(F.lds + RING_OFF, g, S, E);
        { const int wv = F.wave * F.G + F.vcu, nwv = F.G * NWAVES; const float* MF = WSP(const float, WS_MODF); float* SW = WSP(float, WS_SW);
          LAS bf16_t* shl = (LAS bf16_t*)(F.lds + RING_OFF);
          stage_shift3(F, MF, shl);
          for (int blk = wv; blk < 256 + 240 + 256; blk += nwv) {
              if (blk < 256) sw_block(F, WSP(const bf16_t, WS_W1), 4096, blk, shl, SW);
              else if (blk < 496) sw_block(F, WSP(const bf16_t, WS_W_CDIN), PW, blk - 256, shl + 4096, SW + SW_OFF1);
              else sw_block(F, WSP(const bf16_t, WS_W1) + (size_t)4096 * 1024, 4096, blk - 496, shl + 8192, SW + SW_OFF2); } } } SEAM(7);
    PHASE(9) { PHASE_ARGS(); Gemm g{WSP(bf16_t, WS_H), WSP(const bf16_t, WS_W1), 1024, 1024, 1024}; Sched<SM_STD> S; S.init(64, 16, F.G, bx);
        EpiRelu2N E{WSP(bf16_t, WS_BIG), WSP(const float, WS_SSQ), WSP(const float, WS_SW), -1, {}};
        { Unit u0; if (S.next(0, u0)) { E.pm0 = u0.pm; load_rstd(E.rs0, E.SSQ, u0.pm * 256 + (F.wave >> 2) * 64 + (F.lane & 15), F.lane >> 4); } }
        gemm_phase<EpiRelu2N, Sched<SM_STD>, true>(F.lds + RING_OFF, g, S, E); } SEAM(9);
    PHASE(10) { PHASE_ARGS(); Gemm g{WSP(bf16_t, WS_BIG), WSP(const bf16_t, WS_W2), 4096, 4096, 4096}; Sched<SM_STD> S; S.init(64, 4, F.G, bx);
        EpiResidNorm<false> E{nullptr, (const bf16_t*)ws, (bf16_t*)ws, MODF_GATE(1), WSP(const float, WS_GS) + 4096, WSP(bf16_t, WS_H), WSP(float, WS_SSQ)}; gemm_phase<EpiResidNorm<false>, Sched<SM_STD>, true>(F.lds + RING_OFF, g, S, E); } SEAM(10);
    PHASE(12) { PHASE_ARGS(); Gemm g{WSP(bf16_t, WS_H), WSP(const bf16_t, WS_W_CDIN), 1024, 1024, 1024}; Sched<SM_STD> S; S.init(64, 15, F.G, bx);
        EpiInCDN E{WSP(bf16_t, WS_PROJ), WSP(float, WS_WIF), WSP(const float, WS_SSQ), WSP(const float, WS_SW) + SW_OFF1, -1, {}};
        { Unit u0; if (S.next(0, u0)) { E.pm0 = u0.pm; load_rstd(E.rs0, E.SSQ, u0.pm * 256 + (F.wave >> 2) * 64 + (F.lane & 15), F.lane >> 4); } }
        gemm_phase<EpiInCDN, Sched<SM_STD>, true>(F.lds + RING_OFF, g, S, E); } SEAM(12);
    PHASE(13) { PHASE_ARGS();
        for (int v = F.vcu; v < 256; v += F.G) { const int b = v >> 6, s = v & 63;
            idx_unit(F, a, b, s); idx_unit(F, a, b, 127 - s); idx_unit(F, a, b, 128 + s); idx_unit(F, a, b, 255 - s); }
    } SEAM(13);
    PHASE(14) { PHASE_ARGS();
        const attn_body::bf16* PB = WSP(const attn_body::bf16, WS_PROJ); attn_body::bf16* PO = WSP(attn_body::bf16, WS_PROJ);
        const unsigned long long* MASK = WSP(const unsigned long long, WS_MASK);
        for (int v = F.vcu; v < 256; v += F.G) { const int bh = v >> 3, s = v & 7, b = bh >> 3, h = bh & 7;
#if (PROBE_DUP >> 20) & 1
            attn_body::dsa_unit<8>(b, h, 15 - s, PB + PC_QC, PB + PC_KC, PB + PC_VC, PO + PC_QI, MASK, (char*)lds + RING_OFF);
            attn_body::dsa_unit<8>(b, h, s, PB + PC_QC, PB + PC_KC, PB + PC_VC, PO + PC_QI, MASK, (char*)lds + RING_OFF);
#endif
#if (PROBE_DUP >> 21) & 1
            attn_body::sb_unit<SB_EARLY != 0>(b, h, 15 - s, PB + PC_QD, PB + PC_KD, PB + PC_VD, PO + PC_QI, (char*)lds + RING_OFF);
            attn_body::sb_unit<SB_EARLY != 0>(b, h, s, PB + PC_QD, PB + PC_KD, PB + PC_VD, PO + PC_QI, (char*)lds + RING_OFF);
#endif
#ifndef NO_DSA
            attn_body::dsa_unit<8>(b, h, 15 - s, PB + PC_QC, PB + PC_KC, PB + PC_VC, PO + PC_QC, MASK, (char*)lds + RING_OFF);
#endif
#ifndef NO_SB
            attn_body::sb_unit<SB_EARLY != 0>(b, h, 15 - s, PB + PC_QD, PB + PC_KD, PB + PC_VD, PO + PC_QD, (char*)lds + RING_OFF);
#endif
#ifndef NO_DSA
            attn_body::dsa_unit<8>(b, h, s, PB + PC_QC, PB + PC_KC, PB + PC_VC, PO + PC_QC, MASK, (char*)lds + RING_OFF);
#endif
#ifndef NO_SB
            attn_body::sb_unit<SB_EARLY != 0>(b, h, s, PB + PC_QD, PB + PC_KD, PB + PC_VD, PO + PC_QD, (char*)lds + RING_OFF);
#endif
        }
    } SEAM(14);
    PHASE(15) { PHASE_ARGS(); Gemm g{WSP(bf16_t, WS_PROJ), WSP(const bf16_t, WS_W_CDOUT), PW, 1024, 1024}; Sched<SM_STD> S; S.init(64, 4, F.G, bx);
        EpiResidNorm<false> E{nullptr, (const bf16_t*)ws, (bf16_t*)ws, MODF_GATE(2), WSP(const float, WS_GS) + 8192, WSP(bf16_t, WS_H), WSP(float, WS_SSQ)}; gemm_phase<EpiResidNorm<false>, Sched<SM_STD>, true>(F.lds + RING_OFF, g, S, E); } SEAM(15);
    PHASE(17) { PHASE_ARGS(); Gemm g{WSP(bf16_t, WS_H), WSP(const bf16_t, WS_W1) + (size_t)4096 * 1024, 1024, 1024, 1024}; Sched<SM_STD> S; S.init(64, 16, F.G, bx);
        EpiRelu2N E{WSP(bf16_t, WS_BIG), WSP(const float, WS_SSQ), WSP(const float, WS_SW) + SW_OFF2, -1, {}};
        { Unit u0; if (S.next(0, u0)) { E.pm0 = u0.pm; load_rstd(E.rs0, E.SSQ, u0.pm * 256 + (F.wave >> 2) * 64 + (F.lane & 15), F.lane >> 4); } }
        gemm_phase<EpiRelu2N, Sched<SM_STD>, true>(F.lds + RING_OFF, g, S, E); } SEAM(17);
    PHASE(18) { PHASE_ARGS(); Gemm g{WSP(bf16_t, WS_BIG), WSP(const bf16_t, WS_W2) + (size_t)1024 * 4096, 4096, 4096, 4096}; Sched<SM_STD> S; S.init(64, 4, F.G, bx);
        EpiResidNorm<false, false> E{nullptr, (const bf16_t*)ws, nullptr, MODF_GATE(3), WSP(const float, WS_GS) + 12288, WSP(bf16_t, WS_H), WSP(float, WS_SSQ)};
        gemm_phase<EpiResidNorm<false, false>, Sched<SM_STD>, true>(F.lds + RING_OFF, g, S, E); } SEAM(18);
    PHASE(19) { PHASE_ARGS();
        const bf16_t* Hf = WSP(const bf16_t, WS_H); const float* SSQ = WSP(const float, WS_SSQ); float* outp = a.out;
        for (int row0 = (F.vcu * NWAVES + F.wave) * 4; row0 < MTOK; row0 += F.G * NWAVES * 4) {
            u32x4 hw[4][2]; f32x4 p[4][4];
#pragma unroll
            for (int q = 0; q < 4; ++q) { const f32x4* sp = (const f32x4*)(SSQ + (size_t)(row0 + q) * 16);
#pragma unroll
                for (int e = 0; e < 4; ++e) p[q][e] = sp[e];
#pragma unroll
                for (int j = 0; j < 2; ++j) hw[q][j] = *(const u32x4*)(Hf + (size_t)(row0 + q) * 1024 + 512 * j + 8 * F.lane); }
#pragma unroll
            for (int q = 0; q < 4; ++q) {
                const float ssum = ((p[q][0].x + p[q][0].y) + (p[q][0].z + p[q][0].w)) + ((p[q][1].x + p[q][1].y) + (p[q][1].z + p[q][1].w)) + ((p[q][2].x + p[q][2].y) + (p[q][2].z + p[q][2].w)) + ((p[q][3].x + p[q][3].y) + (p[q][3].z + p[q][3].w));
                const float rstd = 1.f / sqrtf(ssum * (1.f / 1024.f) + EPS);
#pragma unroll
                for (int j = 0; j < 2; ++j) { const size_t o = (size_t)(row0 + q) * 1024 + 512 * j + 8 * F.lane; f32x4 x0, x1; unpack8(hw[q][j], x0, x1);
                    *(f32x4*)(outp + o) = x0 * rstd; *(f32x4*)(outp + o + 4) = x1 * rstd; } } }
    }
#undef IN
#undef SEAM
}

extern "C" void kernel_launch(void* const* d_in, const int* in_sizes, int n_in, void* d_out, int out_size, void* d_ws, size_t ws_size, hipStream_t stream) {
    static int grid = 0;
    if (grid == 0) {
        if (n_in != N_IN || out_size != MTOK * DM || ws_size < WS_END) { fprintf(stderr, "kernel_launch: unexpected shapes (n_in %d out %d ws %zu)\n", n_in, out_size, ws_size); grid = -1; return; }
        int dev = 0, cus = 0;
        if (hipGetDevice(&dev) != hipSuccess || hipDeviceGetAttribute(&cus, hipDeviceAttributeMultiprocessorCount, dev) != hipSuccess) { grid = -1; return; }
        if (hipFuncSetAttribute((const void*)mk_fwd, hipFuncAttributeMaxDynamicSharedMemorySize, LDS_BYTES) != hipSuccess) { fprintf(stderr, "kernel_launch: hipFuncSetAttribute failed\n"); grid = -1; return; }
        int per_cu = 0;
        if (hipOccupancyMaxActiveBlocksPerMultiprocessor(&per_cu, (const void*)mk_fwd, NWAVES * 64, LDS_BYTES) != hipSuccess || per_cu < 1) fprintf(stderr, "kernel_launch: occupancy query reports %d\n", per_cu);
        (void)hipGetLastError();
        grid = cus;
        if (grid < 256) { fprintf(stderr, "kernel_launch: this build assigns fixed roles to 256 workgroups (MI355X: 256 CUs); found %d CUs, nothing launched\n", cus); grid = -1; return; }
        grid = 256;
    }
    if (grid < 0) return;
    Args a{};
    for (int i = 0; i < N_IN; ++i) a.in[i] = (const float*)d_in[i];
    a.out = (float*)d_out; a.ws = (unsigned char*)d_ws;
#if MK_PER_PHASE
    for (int p = 0; p < NPHASE; ++p) { a.ph_lo = p; a.ph_hi = p + 1; hipLaunchKernelGGL(mk_fwd, dim3(grid), dim3(NWAVES * 64), LDS_BYTES, stream, a); }
#else
    if (hipMemsetAsync((char*)d_ws + WS_CTL, 0, CTL_ZERO_BYTES, stream) != hipSuccess) { fprintf(stderr, "kernel_launch: memset failed\n"); return; }
    a.ph_lo = 0; a.ph_hi = NPHASE;
    hipLaunchKernelGGL(mk_fwd, dim3(grid), dim3(NWAVES * 64), LDS_BYTES, stream, a);
#endif
    const hipError_t le = hipPeekAtLastError();
    if (le != hipSuccess) fprintf(stderr, "kernel_launch: launch failed: %s\n", hipGetErrorName(le));
}
```

```cpp
#include <hip/hip_runtime.h>
#include <hip/hip_bf16.h>
#include <cstdio>
#include <cstdint>
#include <cmath>

#define LAS __attribute__((address_space(3)))
#define GAS __attribute__((address_space(1)))
typedef unsigned short bf16_t;
typedef short bf16x8 __attribute__((ext_vector_type(8)));
typedef float f32x4 __attribute__((ext_vector_type(4)));
typedef float f32x2 __attribute__((ext_vector_type(2)));
typedef float f32x16 __attribute__((ext_vector_type(16)));
typedef unsigned u32x4 __attribute__((ext_vector_type(4)));
typedef unsigned u32x2 __attribute__((ext_vector_type(2)));
typedef short s16x4 __attribute__((ext_vector_type(4)));
typedef __bf16 bf16x2_t __attribute__((ext_vector_type(2)));

constexpr int DM = 1024, NB = 4, SEQ = 4096, MTOK = NB * SEQ, FF = 4096;
constexpr int PW = 3840;
constexpr float EPS = 1e-6f;
constexpr float LOG2E = 1.4426950408889634f;
constexpr float C2 = 0.125f * LOG2E;
constexpr size_t WS_XB_LO = (size_t)240 << 20, WS_XB_HI = (size_t)9 << 20;
constexpr int PC_QC = 0, PC_QD = 512, PC_KC = 1024, PC_VC = 1536, PC_KD = 2048, PC_VD = 2560, PC_QI = 3072, PC_KI = 3584, PC_WI = 3648;

__device__ __forceinline__ unsigned cvtpk(float lo, float hi) { f32x2 v = {lo, hi}; bf16x2_t b = __builtin_convertvector(v, bf16x2_t); return __builtin_bit_cast(unsigned, b); }
__device__ __forceinline__ float bf2f(unsigned short h) { return __uint_as_float((unsigned)h << 16); }
__device__ __forceinline__ u32x4 pack8(const f32x4& a, const f32x4& b) { u32x4 w; w.x = cvtpk(a[0], a[1]); w.y = cvtpk(a[2], a[3]); w.z = cvtpk(b[0], b[1]); w.w = cvtpk(b[2], b[3]); return w; }

__device__ __forceinline__ void unpack8(const u32x4& w, f32x4& a, f32x4& b) {
    a = (f32x4){__uint_as_float(w.x << 16), __uint_as_float(w.x & 0xffff0000u), __uint_as_float(w.y << 16), __uint_as_float(w.y & 0xffff0000u)};
    b = (f32x4){__uint_as_float(w.z << 16), __uint_as_float(w.z & 0xffff0000u), __uint_as_float(w.w << 16), __uint_as_float(w.w & 0xffff0000u)};
}
namespace pg8 {
constexpr int BM = 256, BK = 64, HALF = 128, HTB = HALF * BK * 2, STAGE_BYTES = 8 * HTB, NXCD = 8, WGM = 8;
__host__ __device__ __forceinline__ int lds_byte(int r, int c) { const int st = (r >> 4) * 2 + (c >> 5), rr = r & 15, cc = c & 31, ob = rr * 64 + cc * 2; return st * 1024 + (ob ^ (((ob >> 9) & 1) << 5)); }
__host__ __device__ __forceinline__ void stage_rc(int b, int& R, int& C) { const int st = b / 1024, sb = b % 1024, swz = sb ^ (((sb >> 9) & 1) << 5); R = (st >> 1) * 16 + swz / 64; C = (st & 1) * 32 + (swz % 64) / 2; }
__host__ __device__ __forceinline__ int perm32(int rho) { const int n = rho >> 4, i = rho & 15; return 8 * (i >> 2) + 4 * n + (i & 3); }

struct Unit { int pm, pn, am, bn, ak; };
struct Gemm { const bf16_t* A; const bf16_t* Bt; int lda, ldb, K; };

enum { SM_STD = 0, SM_POOL = 1, SM_S5S = 2, SM_S5Y = 3 };
template <int MODE> struct Sched {
    int nM, nN, nwg, G, c;
    __device__ __forceinline__ void init(int nM_, int nN_, int G_, int c_) { nM = nM_; nN = nN_; nwg = nM_ * nN_; G = G_; c = c_; }
    __device__ __forceinline__ bool next(int i, Unit& u) const {
        if (c >= G) return false;
        const long L = (long)i * G + c; if (L >= nwg) return false;
        int pm, pn;
        if (MODE == SM_STD) {
            int wgid = (int)L; { const int q = nwg / NXCD, r = nwg % NXCD, xcd = wgid % NXCD, off = wgid / NXCD; wgid = (xcd < r ? xcd * (q + 1) : r * (q + 1) + (xcd - r) * q) + off; }
            const int nig = WGM * nN, gid = wgid / nig, fm = gid * WGM, gsz = (nM - fm) < WGM ? (nM - fm) : WGM;
            pm = fm + ((wgid % nig) % gsz); pn = (wgid % nig) / gsz;
        } else { pm = (int)L / nN; pn = (int)L % nN; }
        u.pm = pm; u.pn = pn; u.am = pm; u.bn = pn; u.ak = 0;
        if (MODE == SM_POOL) u.ak = 256 * pn;
        if (MODE == SM_S5S) u.bn = pm >> 1;
        if (MODE == SM_S5Y) u.bn = (pm >> 1) * 2 + pn;
        return true;
    }
};

template <class Epi, class SchedT, bool ALIGN_EPI>
__device__ __forceinline__ void gemm_phase(LAS unsigned char* lds, const Gemm g, const SchedT& S, const Epi& E) {
    int tid = threadIdx.x; asm volatile("" : "+v"(tid));
    const int wid = __builtin_amdgcn_readfirstlane(tid >> 6), lane = tid & 63, wr = wid >> 2, wc = wid & 3, fr = lane & 15, fq = lane >> 4;
    int K = g.K; asm volatile("" : "+s"(K));
    const int nt = K / BK;
    unsigned voffA[2], voffB[2];
#pragma unroll
    for (int i = 0; i < 2; ++i) { int R, C; stage_rc(tid * 16 + i * 8192, R, C); const int Rb = Epi::PERM ? ((R & ~31) + perm32(R & 31)) : R;
        voffA[i] = (unsigned)(R * g.lda + C) * 2u; voffB[i] = (unsigned)(Rb * g.ldb + C) * 2u; }
    const size_t kstep = (size_t)(BK * 2);
    const size_t hstepA = (size_t)HALF * g.lda * 2, hstepB = (size_t)HALF * g.ldb * 2;
    const unsigned ldsw = (unsigned)wid * 1024u;
    const int aoff = lds_byte(wr * 64 + fr, fq * 8), boff = lds_byte(wc * 32 + fr, fq * 8);
#define PG8_SA(b, h) (((b) * 2 + (h)) * HTB)
#define PG8_SB(b, h) ((4 + (b) * 2 + (h)) * HTB)
#define PG8_STAGE(bufoff, gbase, voff) do { _Pragma("unroll") for (int _i = 0; _i < 2; ++_i) \
        __builtin_amdgcn_global_load_lds((const unsigned*)((const char*)(gbase) + (voff)[_i]), (LAS unsigned*)(lds + (bufoff) + ldsw + _i * 8192), 16, 0, 0); } while (0)
#define PG8_LDA(dst, b, h) do { _Pragma("unroll") for (int m = 0; m < 4; ++m) _Pragma("unroll") for (int k = 0; k < 2; ++k) dst[m][k] = *(const LAS bf16x8*)(lds + PG8_SA(b, h) + aoff + m * 2048 + k * 1024); } while (0)
#define PG8_LDB(dst, b, h) do { _Pragma("unroll") for (int n = 0; n < 2; ++n) _Pragma("unroll") for (int k = 0; k < 2; ++k) dst[n][k] = *(const LAS bf16x8*)(lds + PG8_SB(b, h) + boff + n * 2048 + k * 1024); } while (0)
#define PG8_MMA(ai, bj, At, Bt) do { __builtin_amdgcn_s_setprio(1); _Pragma("unroll") for (int m = 0; m < 4; ++m) _Pragma("unroll") for (int n = 0; n < 2; ++n) _Pragma("unroll") for (int k = 0; k < 2; ++k) \
        acc[ai][bj][m][n] = __builtin_amdgcn_mfma_f32_16x16x32_bf16(Bt[n][k], At[m][k], acc[ai][bj][m][n], 0, 0, 0); __builtin_amdgcn_s_setprio(0); } while (0)
#define PG8_WAIT_V(n) asm volatile("s_waitcnt vmcnt(" #n ")" ::: "memory")
#define PG8_WAIT_L(n) asm volatile("s_waitcnt lgkmcnt(" #n ")" ::: "memory")
#define PG8_BAR __builtin_amdgcn_s_barrier()
#define PG8_SCHED __builtin_amdgcn_sched_barrier(0)
#define PG8_ABASE(u) ((const char*)g.A + ((size_t)(u).am * 256 * g.lda + (size_t)(u).ak) * 2)
#define PG8_BBASE(u) ((const char*)g.Bt + ((size_t)(u).bn * 256 * g.ldb) * 2)
    Unit cur, nxt; int ui = 0;
    if (!S.next(0, cur)) return;
    f32x4 acc[2][2][4][2];
#pragma unroll
    for (int a = 0; a < 2; ++a)
#pragma unroll
        for (int b = 0; b < 2; ++b)
#pragma unroll
            for (int m = 0; m < 4; ++m)
#pragma unroll
                for (int n = 0; n < 2; ++n) acc[a][b][m][n] = (f32x4){0.f, 0.f, 0.f, 0.f};
    bf16x8 At[4][2], B0[2][2], B1[2][2];
    const char* cA = PG8_ABASE(cur); const char* cB = PG8_BBASE(cur);
    PG8_STAGE(PG8_SB(0, 0), cB, voffB); PG8_STAGE(PG8_SB(0, 1), cB + hstepB, voffB); PG8_STAGE(PG8_SA(0, 0), cA, voffA); PG8_STAGE(PG8_SA(0, 1), cA + hstepA, voffA);
    if (wr == 1) PG8_BAR;
    PG8_WAIT_V(2); PG8_BAR;
    PG8_STAGE(PG8_SB(1, 0), cB + kstep, voffB); PG8_STAGE(PG8_SA(1, 0), cA + kstep, voffA); PG8_STAGE(PG8_SB(1, 1), cB + hstepB + kstep, voffB);
    PG8_WAIT_V(6); PG8_BAR;
    for (;;) {
        const bool has_next = S.next(ui + 1, nxt);
        const char* nA = has_next ? PG8_ABASE(nxt) : cA; const char* nB = has_next ? PG8_BBASE(nxt) : cB;
        for (int t = 0; t < nt; t += 2) {
            const bool last = (t == nt - 2);
            const char* a1 = cA + (size_t)(t + 1) * kstep;
            const char* a2 = last ? nA : cA + (size_t)(t + 2) * kstep; const char* b2 = last ? nB : cB + (size_t)(t + 2) * kstep;
            const char* a3 = a2 + kstep; const char* b3 = b2 + kstep;
            PG8_LDB(B0, 0, 0); PG8_LDB(B1, 0, 1); PG8_SCHED; PG8_LDA(At, 0, 0); PG8_STAGE(PG8_SA(1, 1), a1 + hstepA, voffA);
            PG8_WAIT_V(8); PG8_WAIT_L(0); PG8_BAR; PG8_MMA(0, 0, At, B0); PG8_MMA(0, 1, At, B1); PG8_BAR; PG8_SCHED;
            PG8_LDA(At, 0, 1); PG8_STAGE(PG8_SB(0, 0), b2, voffB); PG8_STAGE(PG8_SB(0, 1), b2 + hstepB, voffB); PG8_STAGE(PG8_SA(0, 0), a2, voffA);
            PG8_WAIT_V(8); PG8_WAIT_L(0); PG8_BAR; PG8_MMA(1, 0, At, B0); PG8_MMA(1, 1, At, B1); PG8_BAR; PG8_SCHED;
            PG8_LDB(B0, 1, 0); PG8_LDB(B1, 1, 1); PG8_SCHED; PG8_LDA(At, 1, 0); PG8_STAGE(PG8_SA(0, 1), a2 + hstepA, voffA);
            PG8_WAIT_V(8); PG8_WAIT_L(0); PG8_BAR; PG8_MMA(0, 0, At, B0); PG8_MMA(0, 1, At, B1); PG8_BAR; PG8_SCHED;
            PG8_LDA(At, 1, 1); PG8_STAGE(PG8_SB(1, 0), b3, voffB); PG8_STAGE(PG8_SB(1, 1), b3 + hstepB, voffB); PG8_STAGE(PG8_SA(1, 0), a3, voffA);
            PG8_WAIT_V(8); PG8_WAIT_L(0); PG8_BAR; PG8_MMA(1, 0, At, B0); PG8_MMA(1, 1, At, B1); PG8_BAR; PG8_SCHED;
        }
        if constexpr (ALIGN_EPI) { if (wr == 0) PG8_BAR; }
        E(acc, cur, wr, wc, fr, fq);
        if (!has_next) break;
#pragma unroll
        for (int a = 0; a < 2; ++a)
#pragma unroll
            for (int b = 0; b < 2; ++b)
#pragma unroll
                for (int m = 0; m < 4; ++m)
#pragma unroll
                    for (int n = 0; n < 2; ++n) acc[a][b][m][n] = (f32x4){0.f, 0.f, 0.f, 0.f};
        cur = nxt; cA = nA; cB = nB; ++ui;
        if constexpr (ALIGN_EPI) { if (wr == 1) PG8_BAR; }
    }
    PG8_WAIT_V(0);
    if constexpr (!ALIGN_EPI) { if (wr == 0) PG8_BAR; }
    PG8_BAR;
#undef PG8_SA
#undef PG8_SB
#undef PG8_STAGE
#undef PG8_LDA
#undef PG8_LDB
#undef PG8_MMA
#undef PG8_WAIT_V
#undef PG8_WAIT_L
#undef PG8_BAR
#undef PG8_SCHED
#undef PG8_ABASE
#undef PG8_BBASE
}

#define EPI_ROWS_BEGIN(PERMV) const int row0 = u.pm * BM + wr * 64 + fr; const int colb = u.pn * BM + wc * 32 + ((PERMV) ? 8 : 4) * fq; \
    _Pragma("unroll") for (int ai = 0; ai < 2; ++ai) _Pragma("unroll") for (int m = 0; m < 4; ++m) { const int row = row0 + ai * HALF + m * 16; \
    _Pragma("unroll") for (int bj = 0; bj < 2; ++bj) { const int col = colb + bj * HALF; const f32x4 v0 = acc[ai][bj][m][0], v1 = acc[ai][bj][m][1];
#define EPI_ROWS_END } }

struct EpiInAB {
    static constexpr bool PERM = true;
    bf16_t* UA; bf16_t* UEXT;
    __device__ __forceinline__ void operator()(const f32x4 (&acc)[2][2][4][2], const Unit& u, int wr, int wc, int fr, int fq) const {
        EPI_ROWS_BEGIN(true)
            const u32x4 w = pack8(v0, v1);
            if (col < 512) { *(u32x4*)(UA + (size_t)row * 512 + col) = w; }
            else { const int cc = col - 512, g = cc >> 4, c0 = cc & 15, b = row >> 12, t = row & 4095;
                *(u32x4*)(UEXT + ((size_t)(g * 512 + b * 128 + (t >> 5)) * 640 + (t & 31) * 16 + c0)) = w; }
        EPI_ROWS_END
    }
};
struct EpiStateF32 {
    static constexpr bool PERM = false;
    float* S;
    __device__ __forceinline__ void operator()(const f32x4 (&acc)[2][2][4][2], const Unit& u, int wr, int wc, int fr, int fq) const {
        EPI_ROWS_BEGIN(false)
            if (bj == 0) { *(f32x4*)(S + (size_t)row * 128 + col) = v0; *(f32x4*)(S + (size_t)row * 128 + col + 16) = v1; }
        EPI_ROWS_END
    }
};
struct EpiBf16Plain {
    static constexpr bool PERM = true;
    bf16_t* O; int ldc;
    __device__ __forceinline__ void operator()(const f32x4 (&acc)[2][2][4][2], const Unit& u, int wr, int wc, int fr, int fq) const {
        EPI_ROWS_BEGIN(true)
            *(u32x4*)(O + (size_t)row * ldc + col) = pack8(v0, v1);
        EPI_ROWS_END
    }
};
struct EpiPool {
    static constexpr bool PERM = true;
    bf16_t* CAT; const float* scale;
    __device__ __forceinline__ void operator()(const f32x4 (&acc)[2][2][4][2], const Unit& u, int wr, int wc, int fr, int fq) const {
        EPI_ROWS_BEGIN(true)
            const f32x4 s0 = *(const f32x4*)(scale + col), s1 = *(const f32x4*)(scale + col + 4);
            *(u32x4*)(CAT + (size_t)row * 1024 + col) = pack8(v0 * s0, v1 * s1);
        EPI_ROWS_END
    }
};
__device__ __forceinline__ float gelu_tanh(float x) {
    const float a2 = 1.5957691216057308f * (x + 0.044715f * x * x * x);
    return x * __builtin_amdgcn_rcpf(1.f + __builtin_amdgcn_exp2f(-a2 * LOG2E));
}
struct EpiYGelu {
    static constexpr bool PERM = true;
    bf16_t* YB;
    __device__ __forceinline__ void operator()(const f32x4 (&acc)[2][2][4][2], const Unit& u, int wr, int wc, int fr, int fq) const {
        EPI_ROWS_BEGIN(true)
            const int g = row >> 9, rr = row & 511, b = rr >> 7, k = rr & 127, i = col >> 4, c0 = col & 15;
            f32x4 a = v0, c = v1;
#pragma unroll
            for (int e = 0; e < 4; ++e) { a[e] = gelu_tanh(a[e]); c[e] = gelu_tanh(c[e]); }
            *(u32x4*)(YB + ((size_t)(b * 4096 + 32 * k + i) * 512 + 16 * g + c0)) = pack8(a, c);
        EPI_ROWS_END
    }
};
struct EpiGlu {
    static constexpr bool PERM = true;
    bf16_t* CAT; const bf16_t* YB; const float* bias;
    __device__ __forceinline__ void operator()(const f32x4 (&acc)[2][2][4][2], const Unit& u, int wr, int wc, int fr, int fq) const {
        EPI_ROWS_BEGIN(true)
            const f32x4 b0 = *(const f32x4*)(bias + col), b1 = *(const f32x4*)(bias + col + 4);
            const u32x4 yw = *(const u32x4*)(YB + (size_t)row * 512 + col);
            f32x4 a = v0 + b0, c = v1 + b1;
#pragma unroll
            for (int e = 0; e < 4; ++e) {
                const unsigned wa = yw[e >> 1], wb = yw[2 + (e >> 1)];
                const float ya = (e & 1) ? __uint_as_float(wa & 0xffff0000u) : __uint_as_float(wa << 16);
                const float yc = (e & 1) ? __uint_as_float(wb & 0xffff0000u) : __uint_as_float(wb << 16);
                a[e] = ya * __builtin_amdgcn_rcpf(1.f + __builtin_amdgcn_exp2f(-a[e] * LOG2E));
                c[e] = yc * __builtin_amdgcn_rcpf(1.f + __builtin_amdgcn_exp2f(-c[e] * LOG2E));
            }
            *(u32x4*)(CAT + (size_t)row * 1024 + 512 + col) = pack8(a, c);
        EPI_ROWS_END
    }
};
struct EpiResid {
    static constexpr bool PERM = true;
    const bf16_t* xbin; float* xout; const float* gate;
    __device__ __forceinline__ void operator()(const f32x4 (&acc)[2][2][4][2], const Unit& u, int wr, int wc, int fr, int fq) const {
        const float* gb = gate + (size_t)((u.pm * BM) >> 12) * 3072;
        const size_t xboff = (u.pm < 32) ? (size_t)(WS_XB_LO / 2) : (size_t)(WS_XB_HI / 2) - (size_t)8192 * 1024;
        EPI_ROWS_BEGIN(true)
            const size_t o = (size_t)row * 1024 + col;
            const f32x4 g0 = *(const f32x4*)(gb + col), g1 = *(const f32x4*)(gb + col + 4);
            f32x4 x0, x1; unpack8(*(const u32x4*)(xbin + xboff + o), x0, x1);
            *(f32x4*)(xout + o) = x0 + (g0 + 1.f) * v0; *(f32x4*)(xout + o + 4) = x1 + (g1 + 1.f) * v1;
        EPI_ROWS_END
    }
};
struct EpiRelu2 {
    static constexpr bool PERM = true;
    bf16_t* HID;
    __device__ __forceinline__ void operator()(const f32x4 (&acc)[2][2][4][2], const Unit& u, int wr, int wc, int fr, int fq) const {
        EPI_ROWS_BEGIN(true)
            f32x4 a = v0, c = v1;
#pragma unroll
            for (int e = 0; e < 4; ++e) { const float p = fmaxf(a[e], 0.f), q = fmaxf(c[e], 0.f); a[e] = p * p; c[e] = q * q; }
            *(u32x4*)(HID + (size_t)row * FF + col) = pack8(a, c);
        EPI_ROWS_END
    }
};
struct EpiInCD {
    static constexpr bool PERM = true;
    bf16_t* PROJ; float* WI;
    __device__ __forceinline__ void operator()(const f32x4 (&acc)[2][2][4][2], const Unit& u, int wr, int wc, int fr, int fq) const {
        const float sc = (u.pn < 4) ? C2 : 1.f;
        EPI_ROWS_BEGIN(true)
            *(u32x4*)(PROJ + (size_t)row * PW + col) = pack8(v0 * sc, v1 * sc);
            if (col == PC_WI) { *(f32x4*)(WI + (size_t)row * 8) = v0; *(f32x4*)(WI + (size_t)row * 8 + 4) = v1; }
        EPI_ROWS_END
    }
};
template <bool XIN_F32, bool WRITE_XB = true> struct EpiResidNorm {
    static constexpr bool PERM = true;
    const float* xin; const bf16_t* xbin; bf16_t* xbout; const float* gate; const float* gs; bf16_t* H; float* SSQ;
    __device__ __forceinline__ void operator()(const f32x4 (&acc)[2][2][4][2], const Unit& u, int wr, int wc, int fr, int fq) const {
        const int b = (u.pm * BM) >> 12; const float* gb = gate + (size_t)b * 3072; const float* gsb = gs + (size_t)b * 1024;
        const int row0 = u.pm * BM + wr * 64 + fr, colb = u.pn * BM + wc * 32 + 8 * fq;
        const size_t xboff = (u.pm < 32) ? (size_t)(WS_XB_LO / 2) : (size_t)(WS_XB_HI / 2) - (size_t)8192 * 1024;
        float ss[8];
#pragma unroll
        for (int r = 0; r < 8; ++r) ss[r] = 0.f;
#pragma unroll
        for (int bj = 0; bj < 2; ++bj) { const int col = colb + bj * HALF;
            const f32x4 g0 = *(const f32x4*)(gb + col) + 1.f, g1 = *(const f32x4*)(gb + col + 4) + 1.f, s0 = *(const f32x4*)(gsb + col), s1 = *(const f32x4*)(gsb + col + 4);
#pragma unroll
            for (int ai = 0; ai < 2; ++ai)
#pragma unroll
                for (int m = 0; m < 4; ++m) { const size_t o = (size_t)(row0 + ai * HALF + m * 16) * 1024 + col;
                    f32x4 x0, x1;
                    if (XIN_F32) { x0 = *(const f32x4*)(xin + o); x1 = *(const f32x4*)(xin + o + 4); } else unpack8(*(const u32x4*)(xbin + xboff + o), x0, x1);
                    x0 = x0 + g0 * acc[ai][bj][m][0]; x1 = x1 + g1 * acc[ai][bj][m][1];
                    if (WRITE_XB) *(u32x4*)(xbout + xboff + o) = pack8(x0, x1);
                    ss[ai * 4 + m] += ((x0.x * x0.x + x0.y * x0.y) + (x0.z * x0.z + x0.w * x0.w)) + ((x1.x * x1.x + x1.y * x1.y) + (x1.z * x1.z + x1.w * x1.w));
                    *(u32x4*)(H + o) = pack8(x0 * s0, x1 * s1); } }
#pragma unroll
        for (int r = 0; r < 8; ++r) { float s = ss[r]; s += __shfl_xor(s, 16); s += __shfl_xor(s, 32);
            if (fq == 0) SSQ[(size_t)(row0 + (r >> 2) * HALF + (r & 3) * 16) * 16 + u.pn * 4 + wc] = s; }
    }
};
__device__ __forceinline__ void load_rstd(float (&rs)[8], const float* SSQ, int row0, int fq) {
#pragma unroll
    for (int r = 0; r < 8; ++r) { const f32x4 p = *(const f32x4*)(SSQ + (size_t)(row0 + (r >> 2) * HALF + (r & 3) * 16) * 16 + 4 * fq);
        float s = (p.x + p.y) + (p.z + p.w); s += __shfl_xor(s, 16); s += __shfl_xor(s, 32); rs[r] = 1.f / sqrtf(s * (1.f / 1024.f) + EPS); }
}
struct EpiRelu2N {
    static constexpr bool PERM = true;
    bf16_t* HID; const float* SSQ; const float* SW;
    int pm0; float rs0[8];
    __device__ __forceinline__ void operator()(const f32x4 (&acc)[2][2][4][2], const Unit& u, int wr, int wc, int fr, int fq) const {
        const int row0 = u.pm * BM + wr * 64 + fr, colb = u.pn * BM + wc * 32 + 8 * fq; const float* swb = SW + (size_t)((u.pm * BM) >> 12) * FF;
        float rs[8];
        if (u.pm == pm0) {
#pragma unroll
            for (int r = 0; r < 8; ++r) rs[r] = rs0[r];
        } else load_rstd(rs, SSQ, row0, fq);
#pragma unroll
        for (int bj = 0; bj < 2; ++bj) { const int col = colb + bj * HALF; const f32x4 s0 = *(const f32x4*)(swb + col), s1 = *(const f32x4*)(swb + col + 4);
#pragma unroll
            for (int ai = 0; ai < 2; ++ai)
#pragma unroll
                for (int m = 0; m < 4; ++m) { const float r = rs[ai * 4 + m]; f32x4 a = acc[ai][bj][m][0] * r + s0, c = acc[ai][bj][m][1] * r + s1;
#pragma unroll
                    for (int e = 0; e < 4; ++e) { const float p = fmaxf(a[e], 0.f), q = fmaxf(c[e], 0.f); a[e] = p * p; c[e] = q * q; }
                    *(u32x4*)(HID + (size_t)(row0 + ai * HALF + m * 16) * FF + col) = pack8(a, c); } }
    }
};
struct EpiInCDN {
    static constexpr bool PERM = true;
    bf16_t* PROJ; float* WI; const float* SSQ; const float* SW;
    int pm0; float rs0[8];
    __device__ __forceinline__ void operator()(const f32x4 (&acc)[2][2][4][2], const Unit& u, int wr, int wc, int fr, int fq) const {
        const int row0 = u.pm * BM + wr * 64 + fr, colb = u.pn * BM + wc * 32 + 8 * fq; const float* swb = SW + (size_t)((u.pm * BM) >> 12) * PW;
        const float sc = (u.pn < 4) ? C2 : 1.f;
        float rs[8];
        if (u.pm == pm0) {
#pragma unroll
            for (int r = 0; r < 8; ++r) rs[r] = rs0[r];
        } else load_rstd(rs, SSQ, row0, fq);
#pragma unroll
        for (int bj = 0; bj < 2; ++bj) { const int col = colb + bj * HALF; const f32x4 s0 = *(const f32x4*)(swb + col), s1 = *(const f32x4*)(swb + col + 4);
#pragma unroll
            for (int ai = 0; ai < 2; ++ai)
#pragma unroll
                for (int m = 0; m < 4; ++m) { const float r = rs[ai * 4 + m]; const int row = row0 + ai * HALF + m * 16; const f32x4 a = acc[ai][bj][m][0] * r + s0, c = acc[ai][bj][m][1] * r + s1;
                    *(u32x4*)(PROJ + (size_t)row * PW + col) = pack8(a * sc, c * sc);
                    if (col == PC_WI) { *(f32x4*)(WI + (size_t)row * 8) = a; *(f32x4*)(WI + (size_t)row * 8 + 4) = c; } } }
    }
};
}

namespace attn_body {
using bf16 = __hip_bfloat16;
constexpr int D = 64, PITCH = PW;
constexpr int NW = 8, QBLK = 32, QB = QBLK * NW, KVBLK = 64;
__device__ __forceinline__ int crow(int r, int hi) { return (r & 3) + 8 * (r >> 2) + 4 * hi; }
#define SBAR() __builtin_amdgcn_sched_barrier(0)
constexpr int NSLOT = 3, SLOTB = 8192;
constexpr int LDS_K = 0, LDS_V = NSLOT * SLOTB, LDS_WS = 2 * NSLOT * SLOTB, LDS_OST = LDS_WS + NW * 64 * 4, LDS_FLAG = LDS_OST + NW * 4096, LDS_BYTES = LDS_FLAG + 256;
constexpr float MASKV = -3.0e38f;
__device__ __forceinline__ void glds16(const void* gsrc, unsigned lds_dst) { unsigned keep;
  asm volatile("s_mov_b32 %0, m0\n\ts_mov_b32 m0, %2\n\ts_nop 0\n\tglobal_load_lds_dwordx4 %1, off\n\ts_mov_b32 m0, %0" : "=&s"(keep) : "v"(gsrc), "s"(lds_dst) : "memory"); }
__device__ __forceinline__ float max3f(float a, float b, float c) { float r; asm("v_max3_f32 %0, %1, %2, %3" : "=v"(r) : "v"(a), "v"(b), "v"(c)); return r; }
__device__ __forceinline__ float max2f(float a, float b) { float r; asm("v_max_f32_e32 %0, %1, %2" : "=v"(r) : "v"(a), "v"(b)); return r; }
__device__ __forceinline__ float fadd_s(float a, float b) { float r; asm("v_add_f32_e32 %0, %1, %2" : "=v"(r) : "v"(a), "v"(b)); return r; }
__device__ __forceinline__ float fsub_s(float a, float b) { float r; asm("v_sub_f32_e32 %0, %1, %2" : "=v"(r) : "v"(a), "v"(b)); return r; }
__device__ __forceinline__ unsigned cvtpk_s(float lo, float hi) { return cvtpk(lo, hi); }
#define WAIT_BAR(N) asm volatile("s_waitcnt vmcnt(" #N ") lgkmcnt(0)\n\ts_barrier" ::: "memory")

__device__ __forceinline__ void qkt(f32x16& p0, f32x16& p1, const char* Kslot, const bf16x8* qr, const f32x16& negm, int r32, int hi) {
  const char* kb = Kslot + hi * 1024 + r32 * 16;
  #pragma unroll
  for (int d0 = 0; d0 < 4; ++d0) {
    const bf16x8 b0 = *reinterpret_cast<const bf16x8*>(kb + d0 * 2048);
    const bf16x8 b1 = *reinterpret_cast<const bf16x8*>(kb + d0 * 2048 + 512);
    if (d0 == 0) { p0 = __builtin_amdgcn_mfma_f32_32x32x16_bf16(b0, qr[0], negm, 0, 0, 0); p1 = __builtin_amdgcn_mfma_f32_32x32x16_bf16(b1, qr[0], negm, 0, 0, 0); }
    else { p0 = __builtin_amdgcn_mfma_f32_32x32x16_bf16(b0, qr[d0], p0, 0, 0, 0); p1 = __builtin_amdgcn_mfma_f32_32x32x16_bf16(b1, qr[d0], p1, 0, 0, 0); } }
}
typedef __attribute__((address_space(3))) const char* lds_cptr;
typedef short v4i16_t __attribute__((ext_vector_type(4)));
__device__ __forceinline__ void kload8(bf16x8* kf, lds_cptr kp) {
  kf[0] = *(const LAS bf16x8*)(kp);        kf[1] = *(const LAS bf16x8*)(kp + 512);
  kf[2] = *(const LAS bf16x8*)(kp + 2048); kf[3] = *(const LAS bf16x8*)(kp + 2560);
  kf[4] = *(const LAS bf16x8*)(kp + 4096); kf[5] = *(const LAS bf16x8*)(kp + 4608);
  kf[6] = *(const LAS bf16x8*)(kp + 6144); kf[7] = *(const LAS bf16x8*)(kp + 6656);
}
__device__ __forceinline__ void kload2(bf16x8* kf, lds_cptr kp, int j) { kf[2 * j] = *(const LAS bf16x8*)(kp + j * 2048); kf[2 * j + 1] = *(const LAS bf16x8*)(kp + j * 2048 + 512); }
__device__ __forceinline__ s16x4 vtr(lds_cptr p) { return __builtin_bit_cast(s16x4, __builtin_amdgcn_ds_read_tr16_b64_v4i16((LAS v4i16_t*)p)); }
__device__ __forceinline__ float rowmax(const f32x16& p0, const f32x16& p1) {
  float a = max3f(p0[0], p0[1], p1[0]), b = max3f(p0[2], p0[3], p1[1]); a = max3f(a, p1[2], p1[3]);
  #pragma unroll
  for (int r = 4; r < 16; r += 4) { a = max3f(a, p0[r], p0[r + 1]); b = max3f(b, p0[r + 2], p0[r + 3]); a = max3f(a, p1[r], p1[r + 1]); b = max3f(b, p1[r + 2], p1[r + 3]); }
  const float m = max2f(a, b);
  auto rr = __builtin_amdgcn_permlane32_swap(__float_as_uint(m), __float_as_uint(m), false, false);
  return max2f(__uint_as_float(rr[0]), __uint_as_float(rr[1]));
}
__device__ __forceinline__ void pv(f32x16* o, int vb, bf16x8 pa0, bf16x8 pa1, bf16x8 pa2, bf16x8 pa3) {
  #pragma unroll
  for (int d0 = 0; d0 < 2; ++d0) { s16x4 lo[4], hi[4];
    #pragma unroll
    for (int ks = 0; ks < 4; ++ks) {
      asm volatile("ds_read_b64_tr_b16 %0,%1 offset:%c2" : "=&v"(lo[ks]) : "v"(vb), "i"(d0 * 4096 + ks * 1024) : "memory");
      asm volatile("ds_read_b64_tr_b16 %0,%1 offset:%c2" : "=&v"(hi[ks]) : "v"(vb), "i"(d0 * 4096 + ks * 1024 + 512) : "memory"); }
    asm volatile("s_waitcnt lgkmcnt(0)" ::: "memory"); SBAR();
    #define PK(k) (bf16x8){lo[k][0], lo[k][1], lo[k][2], lo[k][3], hi[k][0], hi[k][1], hi[k][2], hi[k][3]}
    o[d0] = __builtin_amdgcn_mfma_f32_32x32x16_bf16(pa0, PK(0), o[d0], 0, 0, 0);
    o[d0] = __builtin_amdgcn_mfma_f32_32x32x16_bf16(pa1, PK(1), o[d0], 0, 0, 0);
    o[d0] = __builtin_amdgcn_mfma_f32_32x32x16_bf16(pa2, PK(2), o[d0], 0, 0, 0);
    o[d0] = __builtin_amdgcn_mfma_f32_32x32x16_bf16(pa3, PK(3), o[d0], 0, 0, 0);
    #undef PK
  }
}
__device__ __forceinline__ void dsa_mask(f32x16& p0, f32x16& p1, unsigned long long w, float dbase, float sl2, int hi, float mref, bool past) {
  const unsigned lo = (unsigned)w >> (4 * hi), up = (unsigned)(w >> 32) >> (4 * hi);
  const float e0 = -__builtin_fmaf(sl2, dbase, mref), e1 = __builtin_fmaf(sl2, 32.f, e0);
  #pragma unroll
  for (int r = 0; r < 16; ++r) { const int kvc = (r & 3) + 8 * (r >> 2); p0[r] = __builtin_fmaf(sl2, (float)kvc, p0[r] + e0); p1[r] = __builtin_fmaf(sl2, (float)kvc, p1[r] + e1); }
  if (!past) { const float s2 = sl2 + sl2;
    #pragma unroll
    for (int r = 0; r < 16; ++r) { const int kvc = (r & 3) + 8 * (r >> 2); const float d0 = dbase - (float)kvc, d1 = d0 - 32.f;
      p0[r] = __builtin_fmaf(s2, __builtin_fminf(d0, 0.f), p0[r]); p1[r] = __builtin_fmaf(s2, __builtin_fminf(d1, 0.f), p1[r]); } }
  #pragma unroll
  for (int r = 0; r < 16; ++r) { const int kvc = (r & 3) + 8 * (r >> 2);
    const unsigned t0 = (unsigned)__builtin_amdgcn_sbfe((int)lo, kvc, 1), t1 = (unsigned)__builtin_amdgcn_sbfe((int)up, kvc, 1);
    float r0, r1;
    asm("v_bfi_b32 %0, %1, %2, %3" : "=v"(r0) : "v"(t0), "v"(p0[r]), "s"(MASKV)); asm("v_bfi_b32 %0, %1, %2, %3" : "=v"(r1) : "v"(t1), "v"(p1[r]), "s"(MASKV));
    p0[r] = r0; p1[r] = r1; }
}

#ifndef ATTN_STORE16
#define ATTN_STORE16(p, v) (*(u32x4*)(p) = (v))
#endif
template <int THRL> __device__ __forceinline__ void dsa_unit(int b, int h, int qb, const bf16* Q, const bf16* __restrict__ K, const bf16* __restrict__ V, bf16* O, const unsigned long long* __restrict__ MASK, char* shm) {
  int tid = threadIdx.x; asm volatile("" : "+v"(tid)); const int lane = tid & 63, r32 = lane & 31, hi = lane >> 5; const int wid = __builtin_amdgcn_readfirstlane(tid >> 6);
  const long rowbase = (long)b * SEQ; const int q0 = qb * QB;
  const bf16* Qw = Q + (rowbase + q0 + wid * QBLK) * PITCH + h * D;
  const bf16* Kh = K + rowbase * PITCH + h * D, *Vh = V + rowbase * PITCH + h * D;
  const unsigned lds0 = (unsigned)(uintptr_t)shm;
  float* wsf = (float*)(shm + LDS_WS) + wid * 64;
  const bf16* ksrc = Kh + (long)lane * PITCH + wid * 8;
  const bf16* vsrc = Vh + (long)(16 * (wid & 3) + (lane >> 2)) * PITCH + (wid >> 2) * 32 + (lane & 3) * 8;
  const unsigned kdst = lds0 + LDS_K + wid * 1024, vdst = lds0 + LDS_V + wid * 1024;
  #define DMA_K(t, slot) glds16(ksrc + (long)(t) * KVBLK * PITCH, (unsigned)__builtin_amdgcn_readfirstlane(kdst + (slot)))
  #define DMA_V(t, slot) glds16(vsrc + (long)(t) * KVBLK * PITCH, (unsigned)__builtin_amdgcn_readfirstlane(vdst + (slot)))
  const int vb0 = (int)(lds0 + LDS_V) + ((lane >> 4) & 1) * 32 + (lane & 3) * 8 + (4 * hi + ((lane & 15) >> 2)) * 64;
  const char* Kbase = shm + LDS_K; bf16x8 kf[8];
  const lds_cptr shm3 = (lds_cptr)shm; const lds_cptr kp0 = shm3 + LDS_K + hi * 1024 + r32 * 16; const lds_cptr vp0 = shm3 + LDS_V + ((lane >> 4) & 1) * 32 + (lane & 3) * 8 + (4 * hi + ((lane & 15) >> 2)) * 64;
  const int NT = (q0 + QB) / KVBLK;
  #define PT(t) (NT - 1 - (t))
  DMA_K(PT(0), 0); DMA_V(PT(0), 0); DMA_K(PT(1), SLOTB);
  bf16x8 qr[4];
  #pragma unroll
  for (int d0 = 0; d0 < 4; ++d0) qr[d0] = *reinterpret_cast<const bf16x8*>(&Qw[(long)r32 * PITCH + d0 * 16 + hi * 8]);
  float mhat = 0.f, l_reg = 0.f; f32x16 o[2]; o[0] = f32x16{}; o[1] = f32x16{}; const f32x16 zero16 = f32x16{};
  const int qrel = wid * QBLK + r32;
  const unsigned long long* mrow = MASK + ((size_t)(rowbase + q0 + qrel)) * 64;
  const float sl2 = __builtin_amdgcn_exp2f(-(float)(h + 1)) * LOG2E;
  const float dq = (float)(q0 + qrel - 4 * hi);
  #define CMASK(P0, P1, t, MW) dsa_mask(P0, P1, MW, dq - (float)(64 * PT(t)), sl2, hi, mhat, 64 * PT(t) + 64 <= q0 + wid * QBLK)
  bool resc = false;
  #define START(P0, P1) do { const float rm = rowmax(P0, P1); resc = false; \
    { const float dl = max2f(rm, -4096.f); mhat = fadd_s(mhat, dl); \
      _Pragma("unroll") for (int r = 0; r < 16; ++r) { P0[r] = fsub_s(P0[r], dl); P1[r] = fsub_s(P1[r], dl); } \
      } \
    _Pragma("unroll") for (int r = 0; r < 16; ++r) P0[r] = __builtin_amdgcn_exp2f(P0[r]); } while (0)
  #define RESC() do { if (resc) { asm volatile("s_waitcnt lgkmcnt(0)" ::: "memory"); \
      _Pragma("unroll") for (int d_ = 0; d_ < 2; ++d_) _Pragma("unroll") for (int r = 0; r < 16; ++r) o[d_][r] *= wsf[crow(r, hi)]; } } while (0)
  f32x16 pA0, pA1, pB0, pB1;
  int sl_prev = 0, sl_cur = 0, sl_next = SLOTB;
  #define ROT() do { sl_prev = sl_cur; sl_cur = sl_next; sl_next = (sl_next == (NSLOT - 1) * SLOTB) ? 0 : sl_next + SLOTB; } while (0)
  DMA_K(PT(2), 2 * SLOTB);
  WAIT_BAR(3);
  { const unsigned long long mw0 = mrow[PT(0)];
    qkt(pA0, pA1, Kbase, qr, zero16, r32, hi); asm volatile("s_nop 15\n\ts_nop 7" : "+v"(pA0), "+v"(pA1)); CMASK(pA0, pA1, 0, mw0); }
  START(pA0, pA1);
  _Pragma("unroll") for (int r = 0; r < 16; ++r) pA1[r] = __builtin_amdgcn_exp2f(pA1[r]);
  WAIT_BAR(0);
  DMA_K(PT(3), 0); DMA_V(PT(1), SLOTB);
  ROT();
  kload8(kf, kp0 + sl_cur);
  WAIT_BAR(2);
  s16x4 vlo[8], vhi[8]; u32x4 pw0, pw1, pw2, pw3;
  #define PKW(P, B) cvtpk_s(P[B], P[B + 1])
  #define PAF(k) __builtin_bit_cast(bf16x8, pw##k)
  #define VFR(i) (bf16x8){vlo[i][0], vlo[i][1], vlo[i][2], vlo[i][3], vhi[i][0], vhi[i][1], vhi[i][2], vhi[i][3]}
  #define PIN(x) asm volatile("" : "+v"(x))
  #define MX3(a, b, c) __builtin_fmaxf(__builtin_fmaxf((a), (b)), (c))
  #define GAPA(MF, A0, A1, A2, A3, W0, W1, PW_) do { MF; sacc += A0; sacc += A1; sacc += A2; sacc += A3; PIN(sacc); W0; W1; PIN(PW_); SBAR(); } while (0)
  #define EX(v) __builtin_amdgcn_exp2f(v)
  #define GAPB(MF, X, B) do { MF; X[B] = EX(X[B]); X[B + 1] = EX(X[B + 1]); X[B + 2] = EX(X[B + 2]); X[B + 3] = EX(X[B + 3]); PIN(X); SBAR(); } while (0)
  #define VRD(i) do { vlo[i] = vtr(vp_ + (((i) >> 2) * 4096 + ((i) & 3) * 1024)); vhi[i] = vtr(vp_ + (((i) >> 2) * 4096 + ((i) & 3) * 1024 + 512)); } while (0)
  #define KRD(G, j) do { if (G) { kload2(kf, kp0 + sl_next, j); SBAR(); } } while (0)
  #define STEP(C0, C1, P0, P1, t, GK, GV, GL) do { SBAR(); \
    const unsigned long long mw_ = mwn; mwn = mrow[PT((t) + 1)]; \
    const lds_cptr vp_ = vp0 + sl_prev; \
    VRD(0); SBAR(); float sacc = (P0[0] + P0[1]); \
    GAPA(C0 = __builtin_amdgcn_mfma_f32_32x32x16_bf16(kf[0], qr[0], zero16, 0, 0, 0), P0[2], P0[3], P0[4], P0[5],     pw0[0] = PKW(P0, 0), pw0[1] = PKW(P0, 2), pw0); \
    VRD(4); SBAR(); GAPA(C1 = __builtin_amdgcn_mfma_f32_32x32x16_bf16(kf[1], qr[0], zero16, 0, 0, 0), P0[6], P0[7], P0[8], P0[9],     pw0[2] = PKW(P0, 4), pw0[3] = PKW(P0, 6), pw0); \
    VRD(1); SBAR(); GAPA(C0 = __builtin_amdgcn_mfma_f32_32x32x16_bf16(kf[2], qr[1], C0, 0, 0, 0),   P0[10], P0[11], P0[12], P0[13], pw1[0] = PKW(P0, 8), pw1[1] = PKW(P0, 10), pw1); \
    VRD(5); SBAR(); GAPA(C1 = __builtin_amdgcn_mfma_f32_32x32x16_bf16(kf[3], qr[1], C1, 0, 0, 0),   P0[14], P0[15], P1[0], P1[1],   pw1[2] = PKW(P0, 12), pw1[3] = PKW(P0, 14), pw1); \
    VRD(2); SBAR(); GAPA(C0 = __builtin_amdgcn_mfma_f32_32x32x16_bf16(kf[4], qr[2], C0, 0, 0, 0),   P1[2], P1[3], P1[4], P1[5],     pw2[0] = PKW(P1, 0), pw2[1] = PKW(P1, 2), pw2); \
    VRD(6); SBAR(); GAPA(C1 = __builtin_amdgcn_mfma_f32_32x32x16_bf16(kf[5], qr[2], C1, 0, 0, 0),   P1[6], P1[7], P1[8], P1[9],     pw2[2] = PKW(P1, 4), pw2[3] = PKW(P1, 6), pw2); \
    VRD(3); SBAR(); GAPA(C0 = __builtin_amdgcn_mfma_f32_32x32x16_bf16(kf[6], qr[3], C0, 0, 0, 0),   P1[10], P1[11], P1[12], P1[13], pw3[0] = PKW(P1, 8), pw3[1] = PKW(P1, 10), pw3); \
    VRD(7); SBAR(); GAPA(C1 = __builtin_amdgcn_mfma_f32_32x32x16_bf16(kf[7], qr[3], C1, 0, 0, 0),   P1[14], P1[15], 0.f, 0.f,       pw3[2] = PKW(P1, 12), pw3[3] = PKW(P1, 14), pw3); \
    l_reg += sacc; \
    CMASK(C0, C1, t, mw_); \
    if (GK) { DMA_K(PT((t) + 3), sl_cur); } if (GV) { DMA_V(PT((t) + 1), sl_next); } \
    { float a = MX3(C0[0], C0[1], C1[0]), b_ = MX3(C0[2], C0[3], C1[1]); a = MX3(a, C1[2], C1[3]); \
      _Pragma("unroll") for (int r = 4; r < 16; r += 4) { a = MX3(a, C0[r], C0[r + 1]); b_ = MX3(b_, C0[r + 2], C0[r + 3]); a = MX3(a, C1[r], C1[r + 1]); b_ = MX3(b_, C1[r + 2], C1[r + 3]); } \
      float rm = __builtin_fmaxf(a, b_); { auto rr = __builtin_amdgcn_permlane32_swap(__float_as_uint(rm), __float_as_uint(rm), false, false); rm = __builtin_fmaxf(__uint_as_float(rr[0]), __uint_as_float(rr[1])); } \
      resc = false; \
      if (__builtin_expect(__any(rm > (float)THRL), 0)) { const float dl = __builtin_fmaxf(rm, 0.f); mhat += dl; \
        _Pragma("unroll") for (int r = 0; r < 16; ++r) { C0[r] -= dl; C1[r] -= dl; } \
        const float f = __builtin_amdgcn_exp2f(-dl); l_reg *= f; if (hi == 0) wsf[r32] = f; resc = true; } } \
    SBAR(); \
    GAPB(o[0] = __builtin_amdgcn_mfma_f32_32x32x16_bf16(PAF(0), VFR(0), o[0], 0, 0, 0), C0, 0); \
    GAPB(o[1] = __builtin_amdgcn_mfma_f32_32x32x16_bf16(PAF(0), VFR(4), o[1], 0, 0, 0), C0, 4); \
    KRD(GL, 0); GAPB(o[0] = __builtin_amdgcn_mfma_f32_32x32x16_bf16(PAF(1), VFR(1), o[0], 0, 0, 0), C0, 8); \
    KRD(GL, 1); GAPB(o[1] = __builtin_amdgcn_mfma_f32_32x32x16_bf16(PAF(1), VFR(5), o[1], 0, 0, 0), C0, 12); \
    KRD(GL, 2); GAPB(o[0] = __builtin_amdgcn_mfma_f32_32x32x16_bf16(PAF(2), VFR(2), o[0], 0, 0, 0), C1, 0); \
    KRD(GL, 3); GAPB(o[1] = __builtin_amdgcn_mfma_f32_32x32x16_bf16(PAF(2), VFR(6), o[1], 0, 0, 0), C1, 4); \
    GAPB(o[0] = __builtin_amdgcn_mfma_f32_32x32x16_bf16(PAF(3), VFR(3), o[0], 0, 0, 0), C1, 8); \
    GAPB(o[1] = __builtin_amdgcn_mfma_f32_32x32x16_bf16(PAF(3), VFR(7), o[1], 0, 0, 0), C1, 12); \
    } while (0)
  int t = 1;
  unsigned long long mwn = mrow[PT(1)];
  for (; t + 5 < NT; t += 2) {
    STEP(pB0, pB1, pA0, pA1, t, true, true, true);     WAIT_BAR(2); RESC(); ROT();
    STEP(pA0, pA1, pB0, pB1, t + 1, true, true, true); WAIT_BAR(2); RESC(); ROT();
  }
  #define ENDW(tt) do { if ((tt) + 3 < NT) { WAIT_BAR(2); } else if ((tt) + 2 < NT) { WAIT_BAR(1); } else { WAIT_BAR(0); } } while (0)
  for (; t + 1 < NT; t += 2) {
    STEP(pB0, pB1, pA0, pA1, t, (t + 3 < NT), (t + 1 < NT), (t + 1 < NT));       ENDW(t);     RESC(); ROT();
    STEP(pA0, pA1, pB0, pB1, t + 1, (t + 4 < NT), (t + 2 < NT), (t + 2 < NT));   ENDW(t + 1); RESC(); ROT();
  }
  STEP(pB0, pB1, pA0, pA1, NT - 1, false, false, false); RESC();
  { float sacc = pB0[0] + pB0[1]; _Pragma("unroll") for (int r = 2; r < 16; ++r) sacc += pB0[r]; _Pragma("unroll") for (int r = 0; r < 16; ++r) sacc += pB1[r]; l_reg += sacc;
    pw0 = (u32x4){PKW(pB0, 0), PKW(pB0, 2), PKW(pB0, 4), PKW(pB0, 6)}; pw1 = (u32x4){PKW(pB0, 8), PKW(pB0, 10), PKW(pB0, 12), PKW(pB0, 14)}; pw2 = (u32x4){PKW(pB1, 0), PKW(pB1, 2), PKW(pB1, 4), PKW(pB1, 6)}; pw3 = (u32x4){PKW(pB1, 8), PKW(pB1, 10), PKW(pB1, 12), PKW(pB1, 14)};
    SBAR(); pv(o, vb0 + sl_cur, PAF(0), PAF(1), PAF(2), PAF(3)); }
  #undef PKW
  #undef PAF
  #undef VFR
  #undef PIN
  #undef MX3
  #undef GAPA
  #undef GAPB
  #undef EX
  #undef VRD
  #undef KRD
  #undef STEP
  #undef ENDW
  { auto rr = __builtin_amdgcn_permlane32_swap(__float_as_uint(l_reg), __float_as_uint(l_reg), false, false); l_reg = __uint_as_float(rr[0]) + __uint_as_float(rr[1]); }
  if (hi == 0) wsf[32 + r32] = l_reg; asm volatile("s_waitcnt lgkmcnt(0)" ::: "memory");
  float rli[16];
  #pragma unroll
  for (int r = 0; r < 16; ++r) rli[r] = __builtin_amdgcn_rcpf(wsf[32 + crow(r, hi)]);
  bf16* Ow = O + (rowbase + q0 + wid * QBLK) * PITCH + h * D;
  { bf16* stg = (bf16*)(shm + LDS_OST) + wid * 2048;
    #pragma unroll
    for (int r = 0; r < 16; ++r) { const int orow = crow(r, hi);
      #pragma unroll
      for (int d0 = 0; d0 < 2; ++d0) stg[orow * 64 + d0 * 32 + r32] = __float2bfloat16(o[d0][r] * rli[r]); }
    asm volatile("s_waitcnt lgkmcnt(0)" ::: "memory");
    #pragma unroll
    for (int i = 0; i < 4; ++i) { const int row = i * 8 + (lane >> 3), ch = lane & 7; const u32x4 v = *(const u32x4*)(stg + row * 64 + ch * 8); ATTN_STORE16(Ow + (long)row * PITCH + ch * 8, v); } }
  asm volatile("s_waitcnt lgkmcnt(0)\n\ts_barrier" ::: "memory");
  #undef PT
  #undef CMASK
  #undef START
  #undef RESC
  #undef ROT
}

template <bool EARLY> __device__ __forceinline__ void sb_unit(int b, int h, int qb, const bf16* Q, const bf16* __restrict__ K, const bf16* __restrict__ V, bf16* O, char* shm) {
  int tid = threadIdx.x; asm volatile("" : "+v"(tid)); const int lane = tid & 63, r32 = lane & 31, hi = lane >> 5; const int wid = __builtin_amdgcn_readfirstlane(tid >> 6);
  const long rowbase = (long)b * SEQ; const int q0 = qb * QB;
  const bf16* Qw = Q + (rowbase + q0 + wid * QBLK) * PITCH + h * D;
  const bf16* Kh = K + rowbase * PITCH + h * D, *Vh = V + rowbase * PITCH + h * D;
  const unsigned lds0 = (unsigned)(uintptr_t)shm;
  const bf16* ksrc = Kh + (long)lane * PITCH + wid * 8;
  const bf16* vsrc = Vh + (long)(16 * (wid & 3) + (lane >> 2)) * PITCH + (wid >> 2) * 32 + (lane & 3) * 8;
  const unsigned kdst = lds0 + LDS_K + wid * 1024, vdst = lds0 + LDS_V + wid * 1024;
  const int vb0 = (int)(lds0 + LDS_V) + ((lane >> 4) & 1) * 32 + (lane & 3) * 8 + (4 * hi + ((lane & 15) >> 2)) * 64;
  volatile unsigned* flags = (volatile unsigned*)(shm + LDS_FLAG);
  const int NT = (q0 + QB) / KVBLK;
  DMA_K(NT - 1, 0); DMA_V(NT - 1, 0);
  bf16x8 qr[4];
  #pragma unroll
  for (int d0 = 0; d0 < 4; ++d0) qr[d0] = *reinterpret_cast<const bf16x8*>(&Qw[(long)r32 * PITCH + d0 * 16 + hi * 8]);
  f32x16 o[2]; o[0] = f32x16{}; o[1] = f32x16{};
  const f32x16 zero16 = f32x16{};
  const int tq = q0 + wid * QBLK + r32;
  const int tq_lo = q0 + wid * QBLK;
  float carry = 0.f;
  bool wdone = false;
  int it = 0;
  for (int tt = NT - 1; tt >= 0; --tt, ++it) {
    const int cur = (it % 3) * SLOTB, nxtb = ((it + 1) % 3) * SLOTB;
    if (tt > 0) { DMA_K(tt - 1, nxtb); DMA_V(tt - 1, nxtb); WAIT_BAR(2); } else { WAIT_BAR(0); }
    if (EARLY && it > 0) { unsigned all = 1u;
      #pragma unroll
      for (int w8 = 0; w8 < 8; ++w8) all &= flags[((it - 1) & 1) * 8 + w8];
      if (all) break; }
    const int kbase = 64 * tt;
    if (kbase < tq_lo + 31 && !wdone) {
      f32x16 p0, p1;
      qkt(p0, p1, shm + LDS_K + cur, qr, zero16, r32, hi);
      const int lim = tq - kbase - 4 * hi;
      float lk0[16], lk1[16];
      #pragma unroll
      for (int r = 0; r < 16; ++r) { const int kvc = (r & 3) + 8 * (r >> 2);
        const float z0 = __builtin_amdgcn_fmed3f(p0[r], -120.f, 120.f), z1 = __builtin_amdgcn_fmed3f(p1[r], -120.f, 120.f);
        const float s0 = __builtin_amdgcn_logf(1.f + __builtin_amdgcn_exp2f(z0)), s1 = __builtin_amdgcn_logf(1.f + __builtin_amdgcn_exp2f(z1));
        const bool v0 = kvc < lim, v1 = kvc + 32 < lim;
        lk0[r] = v0 ? -s0 : 0.f; lk1[r] = v1 ? -s1 : 0.f;
        p0[r] = v0 ? z0 - s0 : MASKV; p1[r] = v1 ? z1 - s1 : MASKV; }
      float gs[8];
      #pragma unroll
      for (int a = 0; a < 4; ++a) { gs[a] = (lk0[4 * a] + lk0[4 * a + 1]) + (lk0[4 * a + 2] + lk0[4 * a + 3]); gs[4 + a] = (lk1[4 * a] + lk1[4 * a + 1]) + (lk1[4 * a + 2] + lk1[4 * a + 3]); }
      float S[16];
      #pragma unroll
      for (int j = 0; j < 8; ++j) { auto rr = __builtin_amdgcn_permlane32_swap(__float_as_uint(gs[j]), __float_as_uint(gs[j]), false, false); S[2 * j] = __uint_as_float(rr[0]); S[2 * j + 1] = __uint_as_float(rr[1]); }
      float suf[16]; suf[15] = carry;
      #pragma unroll
      for (int G = 14; G >= 0; --G) suf[G] = suf[G + 1] + S[G + 1];
      const float total = suf[0] + S[0];
      #pragma unroll
      for (int j = 0; j < 8; ++j) { float ag = suf[2 * j + 1] + (hi ? 0.f : S[2 * j + 1]);
        if (j < 4) {
          #pragma unroll
          for (int i = 3; i >= 0; --i) { p0[4 * j + i] = __builtin_amdgcn_exp2f(p0[4 * j + i] + ag); ag += lk0[4 * j + i]; }
        } else {
          #pragma unroll
          for (int i = 3; i >= 0; --i) { p1[4 * (j - 4) + i] = __builtin_amdgcn_exp2f(p1[4 * (j - 4) + i] + ag); ag += lk1[4 * (j - 4) + i]; }
        } }
      carry = total;
      u32x4 pw0 = (u32x4){cvtpk(p0[0], p0[1]), cvtpk(p0[2], p0[3]), cvtpk(p0[4], p0[5]), cvtpk(p0[6], p0[7])};
      u32x4 pw1 = (u32x4){cvtpk(p0[8], p0[9]), cvtpk(p0[10], p0[11]), cvtpk(p0[12], p0[13]), cvtpk(p0[14], p0[15])};
      u32x4 pw2 = (u32x4){cvtpk(p1[0], p1[1]), cvtpk(p1[2], p1[3]), cvtpk(p1[4], p1[5]), cvtpk(p1[6], p1[7])};
      u32x4 pw3 = (u32x4){cvtpk(p1[8], p1[9]), cvtpk(p1[10], p1[11]), cvtpk(p1[12], p1[13]), cvtpk(p1[14], p1[15])};
      pv(o, vb0 + cur, __builtin_bit_cast(bf16x8, pw0), __builtin_bit_cast(bf16x8, pw1), __builtin_bit_cast(bf16x8, pw2), __builtin_bit_cast(bf16x8, pw3));
      wdone = EARLY && __all(carry < -134.f);
    }
    if (EARLY) { if (lane == 0) flags[(it & 1) * 8 + wid] = wdone ? 1u : 0u; }
  }
  asm volatile("s_waitcnt lgkmcnt(0)\n\ts_barrier" ::: "memory");
  asm volatile("s_waitcnt vmcnt(0)" ::: "memory");
  bf16* Ow = O + (rowbase + q0 + wid * QBLK) * PITCH + h * D;
  { bf16* stg = (bf16*)(shm + LDS_OST) + wid * 2048;
    #pragma unroll
    for (int r = 0; r < 16; ++r) { const int orow = crow(r, hi);
      #pragma unroll
      for (int d0 = 0; d0 < 2; ++d0) stg[orow * 64 + d0 * 32 + r32] = __float2bfloat16(o[d0][r]); }
    asm volatile("s_waitcnt lgkmcnt(0)" ::: "memory");
    #pragma unroll
    for (int i = 0; i < 4; ++i) { const int row = i * 8 + (lane >> 3), ch = lane & 7; const u32x4 v = *(const u32x4*)(stg + row * 64 + ch * 8); ATTN_STORE16(Ow + (long)row * PITCH + ch * 8, v); } }
  asm volatile("s_waitcnt vmcnt(0) lgkmcnt(0)\n\ts_barrier" ::: "memory");
}
#undef DMA_K
#undef DMA_V
#undef SBAR
#undef WAIT_BAR
constexpr int ATTN_LDS_BYTES = LDS_BYTES;
}

constexpr int NWAVES = 8;
#ifndef MK_PER_PHASE
#define MK_PER_PHASE 0
#endif
#ifndef SB_EARLY
#define SB_EARLY 1
#endif
constexpr int NPHASE = 20;

constexpr size_t MiB = 1u << 20;
constexpr size_t WS_CTL = 0, CTL_ZERO_BYTES = 64 * 1024;
constexpr int NKS = 32;
constexpr size_t WS_MODP = 112 * MiB + 100 * MiB;
constexpr size_t WS_MODF = 3 * MiB;
constexpr size_t WS_APOW = 3 * MiB + 512 * 1024;
constexpr size_t WS_GS = 3 * MiB + 256 * 1024;
constexpr size_t WS_SW = 3 * MiB + 320 * 1024;
constexpr size_t WS_SSQ = 1 * MiB;
constexpr int SW_OFF1 = 4 * 4096, SW_OFF2 = 4 * 4096 + 4 * PW;
constexpr size_t WS_W_ABIN = 4 * MiB, WS_W_ABOUT = 6 * MiB, WS_W_GLU = 8 * MiB, WS_W_POOL = 8 * MiB + 512 * 1024;
constexpr size_t WS_BTY = 9 * MiB;
constexpr size_t WS_BTS = 29 * MiB;
constexpr size_t WS_W1 = 37 * MiB;
constexpr size_t WS_W2 = 53 * MiB;
constexpr size_t WS_W_CDIN = 69 * MiB;
constexpr size_t WS_W_CDOUT = 77 * MiB;
constexpr size_t WS_WIF = 79 * MiB;
constexpr size_t WS_H = 80 * MiB;
constexpr size_t WS_BIG = 112 * MiB;
constexpr size_t WS_UA = WS_BIG, WS_PA = WS_BIG + 16 * MiB, WS_UEXT = WS_BIG + 32 * MiB, WS_SST = WS_BIG + 53 * MiB, WS_YB = WS_BIG + 61 * MiB, WS_CAT = WS_BIG + 77 * MiB;
constexpr size_t WS_PROJ = WS_BIG, WS_MASK = WS_BIG + 120 * MiB;
constexpr size_t WS_END = 256 * MiB;
static_assert(WS_CAT + 32 * MiB <= WS_BIG + 128 * MiB && WS_UEXT + (size_t)32 * 512 * 640 * 2 <= WS_SST && WS_SST + 8 * MiB <= WS_YB, "ws map");
static_assert(WS_MASK + 8 * MiB <= WS_BIG + 128 * MiB && (size_t)MTOK * PW * 2 <= 120 * MiB && WS_BIG + 128 * MiB <= WS_END, "ws map");
constexpr int CW_BAR = 1024;

constexpr int RING_OFF = 0, RING_BYTES = 131072;
constexpr int LDSCTL_OFF = RING_BYTES, MISC_OFF = LDSCTL_OFF + 320;
constexpr int LDS_BYTES = 147456;

typedef GAS unsigned gu32;
#define RLX_AGENT __ATOMIC_RELAXED, __HIP_MEMORY_SCOPE_AGENT

#define XB_TMO      128
#define XB_XCNT(j)  (256  + 64 * (j))
#define XB_XSUB(j)  (1280 + 64 * (j))
#define XB_XGEN(j)  (2304 + 64 * (j))
#define XB_TOP      3328
#define XB_TOPGEN   3392
#define XCD_BAR_WORDS 3456
#define XB_SPIN_CAP (1u << 20)
__device__ __forceinline__ unsigned xb_ld(unsigned* p)              { return __hip_atomic_load(p, __ATOMIC_RELAXED, __HIP_MEMORY_SCOPE_AGENT); }
__device__ __forceinline__ unsigned xb_add(unsigned* p, unsigned v) { return __hip_atomic_fetch_add(p, v, __ATOMIC_RELAXED, __HIP_MEMORY_SCOPE_AGENT); }
__device__ __forceinline__ unsigned xb_xcc_id() { return (unsigned)__builtin_amdgcn_s_getreg((3 << 11) | 20) & 0xFu; }
#define XB_SPIN(cond, bar) do { unsigned _sp = 0; while (cond) { __builtin_amdgcn_s_sleep(1); \
    if ((++_sp & 255u) == 0u) { if (xb_ld(&(bar)[XB_TMO])) break; if (_sp > XB_SPIN_CAP) { atomicAdd(&(bar)[XB_TMO], 1u); break; } } } } while (0)
struct XcdBarrier { unsigned* bar; unsigned x; volatile LAS unsigned* st; };
__device__ __forceinline__ XcdBarrier xcd_barrier_post(unsigned* bar, volatile LAS unsigned* st) {
    XcdBarrier b; b.bar = bar; b.x = xb_xcc_id(); b.st = st;
    if (threadIdx.x == 0) (void)xb_add(&bar[XB_XCNT(b.x)], 1u);
    return b;
}
__device__ __forceinline__ void xcd_barrier_complete(unsigned* bar, unsigned x, unsigned& nloc, unsigned& nx) {
    const unsigned G = gridDim.x * gridDim.y * gridDim.z;
    unsigned sum, cnt, mine, sp = 0u;
    for (;;) {
        sum = 0u; cnt = 0u; mine = 0u;
#pragma unroll
        for (unsigned j = 0; j < 16; ++j) { const unsigned c = xb_ld(&bar[XB_XCNT(j)]); sum += c; cnt += (c > 0u) ? 1u : 0u; mine = (j == x) ? c : mine; }
        if (sum == G) break;
        __builtin_amdgcn_s_sleep(1);
        if ((++sp & 255u) == 0u) { if (xb_ld(&bar[XB_TMO])) break; if (sp > XB_SPIN_CAP) { atomicAdd(&bar[XB_TMO], 1u); break; } }
    }
    nloc = mine > 0u ? mine : 1u; nx = cnt > 0u ? cnt : 1u;
}
__device__ __forceinline__ void xcd_barrier(const XcdBarrier& b) {
    asm volatile("s_waitcnt vmcnt(0)" ::: "memory");
    __syncthreads();
    if (threadIdx.x == 0) {
        unsigned* bar = b.bar;
        __builtin_amdgcn_s_waitcnt(0);
        unsigned nloc = b.st[0], nx = b.st[1];
        if (nloc == 0u) { xcd_barrier_complete(bar, b.x, nloc, nx); b.st[0] = nloc; b.st[1] = nx; }
        const unsigned old = xb_add(&bar[XB_XSUB(b.x)], 1u);
        const unsigned gen = old / nloc;
        if (old + 1u == (gen + 1u) * nloc) {
            asm volatile("buffer_wbl2 sc1\n\tbuffer_inv sc1\n\ts_waitcnt vmcnt(0)" ::: "memory");
            const unsigned og = xb_add(&bar[XB_TOP], 1u);
            const unsigned tg = og / nx;
            if (og + 1u == (tg + 1u) * nx) xb_add(&bar[XB_TOPGEN], 1u);
            else XB_SPIN(xb_ld(&bar[XB_TOPGEN]) == tg, bar);
            xb_add(&bar[XB_XGEN(b.x)], 1u);
            asm volatile("s_waitcnt vmcnt(0)" ::: "memory");
        } else {
            asm volatile("buffer_inv sc1" ::: "memory");
            XB_SPIN(xb_ld(&bar[XB_XGEN(b.x)]) == gen, bar);
            asm volatile("s_waitcnt vmcnt(0)" ::: "memory");
        }
    }
    __syncthreads();
}

enum { I_X = 0, I_C, I_NORMG, I_ADAW, I_ADAB, I_W1, I_W2, I_ABIN, I_ABOUT, I_POOLW, I_POOLS, I_LRE, I_LIM, I_LOGDT, I_BRE, I_BIM, I_CRE, I_CIM, I_SSMD, I_GLUW, I_GLUB, I_CDIN, I_CDOUT, I_FING, N_IN };
struct Args { const float* in[N_IN]; float* out; unsigned char* ws; int ph_lo, ph_hi; };

struct Frame {
    LAS unsigned char* lds;
    int tid, lane, wave, vcu, G;
};

__device__ __forceinline__ float wave_sum(float v) {
#pragma unroll
    for (int o = 1; o < 64; o <<= 1) v += __shfl_xor(v, o);
    return v;
}
#define LDS_WAIT() asm volatile("s_waitcnt lgkmcnt(0)" ::: "memory")

__device__ __forceinline__ void transpose_item(const float* W, int ldw, int n0, int ncols, int k0, bf16_t* WT, int ldo, int drow0, LAS float* scr, int lane) {
    const int r8 = lane >> 3, c4 = (lane & 7) * 4;
    f32x4 v[8];
#pragma unroll
    for (int i = 0; i < 8; ++i) v[i] = (c4 < ncols) ? *(const f32x4*)(W + (size_t)(k0 + r8 + 8 * i) * ldw + n0 + c4) : (f32x4){0.f, 0.f, 0.f, 0.f};
#pragma unroll
    for (int i = 0; i < 8; ++i) { LAS float* d = scr + (r8 + 8 * i) * 33 + c4; d[0] = v[i].x; d[1] = v[i].y; d[2] = v[i].z; d[3] = v[i].w; }
    LDS_WAIT(); asm volatile("" ::: "memory");
    const int c = lane & 7;
#pragma unroll
    for (int j = 0; j < 4; ++j) { const int n = (lane >> 3) + 8 * j; const LAS float* s = scr + (8 * c) * 33 + n;
        u32x4 o; o.x = cvtpk(s[0 * 33], s[1 * 33]); o.y = cvtpk(s[2 * 33], s[3 * 33]); o.z = cvtpk(s[4 * 33], s[5 * 33]); o.w = cvtpk(s[6 * 33], s[7 * 33]);
        if (n < ncols) *(u32x4*)(WT + (size_t)(drow0 + n) * ldo + k0 + 8 * c) = o; }
    LDS_WAIT(); asm volatile("" ::: "memory");
}
__device__ __forceinline__ void transpose_full(const float* W, int K, int N, bf16_t* WT, int item, LAS float* scr, int lane) {
    const int nblk = N / 32, kb = item / nblk, nb = item % nblk;
    transpose_item(W, N, 32 * nb, 32, 64 * kb, WT, K, 32 * nb, scr, lane);
}

__device__ __forceinline__ void sincos_d(double x, float& s, float& c) {
    const double inv2pi = 0.15915494309189535, tp_hi = 6.283185307179586, tp_lo = 2.4492935982947064e-16;
    const double k = __builtin_rint(x * inv2pi);
    double r = __builtin_fma(-k, tp_hi, x); r = __builtin_fma(-k, tp_lo, r);
    const double r2 = r * r;
    double vs = 1.0, vc = 1.0;
#pragma unroll
    for (int j = 15; j >= 1; --j) { vs = 1.0 - r2 * (1.0 / (double)((2 * j) * (2 * j + 1))) * vs; vc = 1.0 - r2 * (1.0 / (double)((2 * j - 1) * (2 * j))) * vc; }
    s = (float)(r * vs); c = (float)vc;
}

__device__ __forceinline__ void s5_tables(const Frame& F, const Args& a, int g, int qtr) {
    LAS float* AP = (LAS float*)(F.lds);
    LAS float* BB = AP + 33 * 64 * 2;
    LAS float* CL = BB + 64 * 16 * 2;
    LAS float* KT = CL + 16 * 64 * 2;
    const float* lre = a.in[I_LRE]; const float* lim = a.in[I_LIM]; const float* ldt = a.in[I_LOGDT];
    const float* bre = a.in[I_BRE]; const float* bim = a.in[I_BIM]; const float* cre = a.in[I_CRE]; const float* cim = a.in[I_CIM]; const float* dsk = a.in[I_SSMD];
    bf16_t* BTY = (bf16_t*)(a.ws + WS_BTY); bf16_t* BTS = (bf16_t*)(a.ws + WS_BTS); float* APOW = (float*)(a.ws + WS_APOW);
    const float dt = expf(ldt[g]);
    __syncthreads();
    for (int idx = F.tid; idx < 33 * 64; idx += 512) { const int n = idx >> 6, p = idx & 63;
        const float lr = lre[g * 64 + p], li = lim[g * 64 + p];
        const float mag = expf((float)n * lr * dt); float s, c; sincos_d((double)li * (double)dt * (double)n, s, c);
        AP[idx * 2] = mag * c; AP[idx * 2 + 1] = mag * s; }
    for (int idx = F.tid; idx < 16 * 64; idx += 512) { CL[idx * 2] = cre[g * 1024 + idx]; CL[idx * 2 + 1] = cim[g * 1024 + idx]; }
    __syncthreads();
    for (int idx = F.tid; idx < 64 * 16; idx += 512) { const int p = idx >> 4, c = idx & 15;
        const float lr = lre[g * 64 + p], li = lim[g * 64 + p], ar = AP[(64 + p) * 2], ai = AP[(64 + p) * 2 + 1];
        const float den = lr * lr + li * li, zr = ((ar - 1.f) * lr + ai * li) / den, zi = (ai * lr - (ar - 1.f) * li) / den;
        const float br = bre[(g * 64 + p) * 16 + c], bi = bim[(g * 64 + p) * 16 + c];
        BB[idx * 2] = zr * br - zi * bi; BB[idx * 2 + 1] = zr * bi + zi * br; }
    __syncthreads();
    { const int j = F.tid >> 4, cl = (F.tid >> 2) & 3, c = 4 * qtr + cl, c2q = F.tid & 3; float acc[4] = {0.f, 0.f, 0.f, 0.f};
        for (int p = 0; p < 64; ++p) { const f32x2 cc = *(const LAS f32x2*)(CL + (c * 64 + p) * 2), aa = *(const LAS f32x2*)(AP + (j * 64 + p) * 2);
            const float car = cc.x * aa.x - cc.y * aa.y, cai = cc.x * aa.y + cc.y * aa.x;
#pragma unroll
            for (int e = 0; e < 4; ++e) { const f32x2 bb = *(const LAS f32x2*)(BB + (p * 16 + 4 * c2q + e) * 2); acc[e] += car * bb.x - cai * bb.y; } }
#pragma unroll
        for (int e = 0; e < 4; ++e) { if (j == 0 && c == 4 * c2q + e) acc[e] += dsk[g * 16 + c]; KT[(j * 4 + cl) * 16 + 4 * c2q + e] = acc[e]; } }
    __syncthreads();
    for (int o = F.tid; o < 128 * 80; o += 512) { const int nl = o / 80, ko = o % 80, i = nl >> 2, cl = nl & 3, c = 4 * qtr + cl, n = i * 16 + c; float v[8];
        if (ko < 64) { const int s = ko >> 1, c20 = (ko & 1) * 8;
#pragma unroll
            for (int q = 0; q < 8; ++q) v[q] = (s <= i) ? KT[((i - s) * 4 + cl) * 16 + c20 + q] : 0.f;
        } else {
#pragma unroll
            for (int q = 0; q < 8; ++q) { const int pp = (ko - 64) * 8 + q, p = pp & 63; const float cr = CL[(c * 64 + p) * 2], ci = CL[(c * 64 + p) * 2 + 1];
                const float ar = AP[((i + 1) * 64 + p) * 2], ai = AP[((i + 1) * 64 + p) * 2 + 1];
                v[q] = (pp < 64) ? (cr * ar - ci * ai) : -(cr * ai + ci * ar); }
        }
        u32x4 w; w.x = cvtpk(v[0], v[1]); w.y = cvtpk(v[2], v[3]); w.z = cvtpk(v[4], v[5]); w.w = cvtpk(v[6], v[7]);
        *(u32x4*)(BTY + ((size_t)(g * 512 + n) * 640 + ko * 8)) = w; }
    for (int o = F.tid; o < 64 * 64; o += 512) { const int pp = 64 * qtr + (o >> 6), ko = o & 63, s = ko >> 1, c20 = (ko & 1) * 8, p = pp & 63; float v[8];
#pragma unroll
        for (int q = 0; q < 8; ++q) { const float ar = AP[((31 - s) * 64 + p) * 2], ai = AP[((31 - s) * 64 + p) * 2 + 1], br = BB[(p * 16 + c20 + q) * 2], bi = BB[(p * 16 + c20 + q) * 2 + 1];
            v[q] = (pp < 64) ? (ar * br - ai * bi) : ((pp < 128) ? (ar * bi + ai * br) : 0.f); }
        u32x4 w; w.x = cvtpk(v[0], v[1]); w.y = cvtpk(v[2], v[3]); w.z = cvtpk(v[4], v[5]); w.w = cvtpk(v[6], v[7]);
        *(u32x4*)(BTS + ((size_t)(g * 256 + pp) * 512 + ko * 8)) = w; }
    if (qtr == 0 && F.tid < 64) { APOW[(g * 64 + F.tid) * 2] = AP[(32 * 64 + F.tid) * 2]; APOW[(g * 64 + F.tid) * 2 + 1] = AP[(32 * 64 + F.tid) * 2 + 1]; }
    __syncthreads();
}

__device__ __forceinline__ void phase_p0a(const Frame& F, const Args& a) {
    const bool split = F.G >= 256;
    if (!split || F.vcu < 128) { for (int it = F.vcu; it < 128; it += F.G) s5_tables(F, a, it >> 2, it & 3); if (split) return; }
    LAS float* scr = (LAS float*)(F.lds + RING_OFF + F.wave * 8704);
    const int gw = (split ? F.vcu - 128 : F.vcu) * NWAVES + F.wave, NGW = (split ? F.G - 128 : F.G) * NWAVES;
    const float* cvec = a.in[I_C]; const float* adaw = a.in[I_ADAW]; float* MODP = (float*)(a.ws + WS_MODP);
    for (int task = gw; task < 4 * 6 * NKS; task += NGW) { const int ks = task % NKS, c6 = (task / NKS) % 6, is = task / (NKS * 6);
        const float* W = adaw + (size_t)is * 1024 * 3072 + c6 * 512 + F.lane * 4; f32x4 acc[4][2];
#pragma unroll
        for (int b = 0; b < 4; ++b) { acc[b][0] = (f32x4){0.f, 0.f, 0.f, 0.f}; acc[b][1] = (f32x4){0.f, 0.f, 0.f, 0.f}; }
        const int kper = 1024 / NKS;
#pragma unroll 8
        for (int k = ks * kper; k < ks * kper + kper; ++k) { const f32x4 w0 = *(const f32x4*)(W + (size_t)k * 3072), w1 = *(const f32x4*)(W + (size_t)k * 3072 + 256);
#pragma unroll
            for (int b = 0; b < 4; ++b) { const float cb = cvec[b * 1024 + k]; acc[b][0] += cb * w0; acc[b][1] += cb * w1; } }
#pragma unroll
        for (int b = 0; b < 4; ++b) { float* o = MODP + ((size_t)((ks * 4 + is) * 4 + b)) * 3072 + c6 * 512 + F.lane * 4; *(f32x4*)o = acc[b][0]; *(f32x4*)(o + 256) = acc[b][1]; } }
    bf16_t* Wabin = (bf16_t*)(a.ws + WS_W_ABIN); bf16_t* Wabout = (bf16_t*)(a.ws + WS_W_ABOUT); bf16_t* Wglu = (bf16_t*)(a.ws + WS_W_GLU); bf16_t* Wpool = (bf16_t*)(a.ws + WS_W_POOL);
    for (int it = gw; it < 512 + 512 + 128; it += NGW) {
        if (it < 512) transpose_full(a.in[I_ABIN], 1024, 1024, Wabin, it, scr, F.lane);
        else if (it < 1024) transpose_full(a.in[I_ABOUT], 1024, 1024, Wabout, it - 512, scr, F.lane);
        else transpose_full(a.in[I_GLUW], 512, 512, Wglu, it - 1024, scr, F.lane);
    }
    const float* pw = a.in[I_POOLW];
    for (int idx = gw * 64 + F.lane; idx < 512 * 256; idx += NGW * 64) { const int n = idx >> 8, kk = idx & 255, g = n >> 7, co = n & 127, half = kk >> 7, ci = kk & 127;
        const float v = (half == (g & 1)) ? pw[((size_t)g * 128 + ci) * 128 + co] : 0.f; Wpool[idx] = (bf16_t)(cvtpk(v, 0.f) & 0xffffu); }
}

template <bool FROM_PARTIALS> __device__ __forceinline__ void norm_mod_rows(const Frame& F, const Args& a, const float* xin, int is, bf16_t* H) {
    LAS float* gs = (LAS float*)(F.lds); LAS float* sh = gs + 1024;
    const float* MODP = (const float*)(a.ws + WS_MODP); const float* MODF = (const float*)(a.ws + WS_MODF); const float* ng = a.in[I_NORMG] + is * 1024; const float* ab = a.in[I_ADAB] + is * 3072;
    for (int rb = F.vcu; rb < MTOK / 64; rb += F.G) { const int b = rb >> 6;
        __syncthreads();
        for (int c = F.tid; c < 1024; c += 512) { float shift, scale;
            if (FROM_PARTIALS) { shift = ab[c]; scale = ab[1024 + c];
#pragma unroll
                for (int ks = 0; ks < NKS; ++ks) { const float* m = MODP + ((size_t)((ks * 4 + is) * 4 + b)) * 3072; shift += m[c]; scale += m[1024 + c]; } }
            else { const float* m = MODF + (size_t)(is * 4 + b) * 3072; shift = m[c]; scale = m[1024 + c]; }
            gs[c] = ng[c] * (1.f + scale); sh[c] = shift; }
        __syncthreads();
        for (int r0 = F.wave * 8; r0 < F.wave * 8 + 8; r0 += 4) {
            f32x4 v[4][4]; float s[4];
#pragma unroll
            for (int q = 0; q < 4; ++q) { const f32x4* xr = (const f32x4*)(xin + ((size_t)rb * 64 + r0 + q) * 1024) + F.lane;
#pragma unroll
                for (int j = 0; j < 4; ++j) v[q][j] = xr[64 * j]; }
#pragma unroll
            for (int q = 0; q < 4; ++q) { s[q] = 0.f;
#pragma unroll
                for (int j = 0; j < 4; ++j) s[q] += (v[q][j].x * v[q][j].x + v[q][j].y * v[q][j].y) + (v[q][j].z * v[q][j].z + v[q][j].w * v[q][j].w); }
#pragma unroll
            for (int o = 1; o < 64; o <<= 1) {
#pragma unroll
                for (int q = 0; q < 4; ++q) s[q] += __shfl_xor(s[q], o); }
#pragma unroll
            for (int q = 0; q < 4; ++q) { const float rstd = 1.f / sqrtf(s[q] * (1.f / 1024.f) + EPS); u32x2* o8 = (u32x2*)(H + ((size_t)rb * 64 + r0 + q) * 1024) + F.lane;
#pragma unroll
                for (int j = 0; j < 4; ++j) { const int c0 = 4 * F.lane + 256 * j; const f32x4 g4 = *(const LAS f32x4*)(gs + c0), s4 = *(const LAS f32x4*)(sh + c0);
                    const f32x4 y = v[q][j] * rstd * g4 + s4; u32x2 w; w.x = cvtpk(y.x, y.y); w.y = cvtpk(y.z, y.w); o8[64 * j] = w; } } }
    }
    __syncthreads();
}

__device__ __forceinline__ void phase_p0b(const Frame& F, const Args& a) {
    { const float* MODP = (const float*)(a.ws + WS_MODP); float* MODF = (float*)(a.ws + WS_MODF); const float* ab = a.in[I_ADAB];
      for (int idx = F.vcu * 512 + F.tid; idx < 16 * 3072; idx += F.G * 512) { const int n = idx % 3072, isb = idx / 3072, is = isb >> 2, b = isb & 3; float s = ab[is * 3072 + n];
#pragma unroll
          for (int ks = 0; ks < NKS; ++ks) s += MODP[((size_t)((ks * 4 + is) * 4 + b)) * 3072 + n];
          MODF[idx] = s; } }
    { const float* MODP = (const float*)(a.ws + WS_MODP); float* GS = (float*)(a.ws + WS_GS); const float* ab = a.in[I_ADAB]; const float* ng = a.in[I_NORMG];
      for (int idx = F.vcu * 512 + F.tid; idx < 4 * 4 * 1024; idx += F.G * 512) { const int c = idx & 1023, b = (idx >> 10) & 3, is = (idx >> 12) + 1;
          if (is == 4) { GS[idx] = a.in[I_FING][c]; continue; }
          float sc = ab[is * 3072 + 1024 + c];
#pragma unroll
          for (int ks = 0; ks < NKS; ++ks) sc += MODP[((size_t)((ks * 4 + is) * 4 + b)) * 3072 + 1024 + c];
          GS[idx] = ng[is * 1024 + c] * (1.f + sc); } }
    norm_mod_rows<true>(F, a, a.in[I_X], 0, (bf16_t*)(a.ws + WS_H));
}

__device__ __forceinline__ void stage_shift3(const Frame& F, const float* MF, LAS bf16_t* shl) {
    __syncthreads();
    for (int idx = F.tid; idx < 3 * 4 * 1024 / 2; idx += 512) { const int ub = idx >> 9, c = (idx & 511) * 2; const float* sp = MF + (size_t)(4 + ub) * 3072 + c; *(LAS unsigned*)(shl + ub * 1024 + c) = cvtpk(sp[0], sp[1]); }
    __syncthreads();
}
__device__ __forceinline__ void sw_block(const Frame& F, const bf16_t* Wt, int N, int blk, const LAS bf16_t* shl, float* SW) {
    const int r = F.lane & 15, kq = F.lane >> 4; const bf16_t* wp = Wt + (size_t)(blk * 16 + r) * 1024 + 8 * kq; f32x4 acc = (f32x4){0.f, 0.f, 0.f, 0.f};
    bf16x8 wf[32];
#pragma unroll
    for (int j = 0; j < 32; ++j) wf[j] = *(const bf16x8*)(wp + 32 * j);
#pragma unroll
    for (int j = 0; j < 32; ++j) { bf16x8 sf = *(const LAS bf16x8*)(shl + (r & 3) * 1024 + 32 * j + 8 * kq); if (r >= 4) sf = (bf16x8){0, 0, 0, 0, 0, 0, 0, 0};
        acc = __builtin_amdgcn_mfma_f32_16x16x32_bf16(sf, wf[j], acc, 0, 0, 0); }
    if (kq == 0) {
#pragma unroll
        for (int b = 0; b < 4; ++b) SW[(size_t)b * N + blk * 16 + r] = acc[b]; }
}

__device__ __forceinline__ void convert_late(const Frame& F, const Args& a, int part, int wv, int nwv, LAS float* scr) {
    bf16_t* W1 = (bf16_t*)(a.ws + WS_W1); bf16_t* W2 = (bf16_t*)(a.ws + WS_W2); bf16_t* Wcdin = (bf16_t*)(a.ws + WS_W_CDIN); bf16_t* Wcdout = (bf16_t*)(a.ws + WS_W_CDOUT);
    constexpr int NSEG = 9;
    const int seg_src[NSEG] = {0, 512, 1024, 1536, 2048, 2112, 2120, 2632, 3144}, seg_w[NSEG] = {512, 512, 512, 512, 64, 8, 512, 512, 512}, seg_dst[NSEG] = {PC_QC, PC_KC, PC_VC, PC_QI, PC_KI, PC_WI, PC_QD, PC_KD, PC_VD};
    constexpr int I_MLP = 2048, I_CDI = 16 * 115  , I_CDO = 512, NIT = 4 * I_MLP + I_CDI + I_CDO;
    const int lo = part == 0 ? 0 : (part == 1 ? 1500 : 6000), hi = part == 0 ? 1500 : (part == 1 ? 6000 : NIT);
    for (int it = lo + wv; it < hi; it += nwv) { int r = it;
        if (r < I_MLP) { transpose_full(a.in[I_W1], 1024, 4096, W1, r, scr, F.lane); continue; } r -= I_MLP;
        if (r < I_MLP) { transpose_full(a.in[I_W2], 4096, 1024, W2, r, scr, F.lane); continue; } r -= I_MLP;
        if (r < I_CDI) { const int kb = r / 115; int nb = r % 115, sg = 0;
#pragma unroll
            for (int q = 0; q < NSEG; ++q) { const int nbq = (seg_w[q] + 31) / 32; if (sg == q && nb >= nbq) { nb -= nbq; sg = q + 1; } }
            const int wdt = seg_w[sg] - 32 * nb < 32 ? seg_w[sg] - 32 * nb : 32;
            transpose_item(a.in[I_CDIN], 3656, seg_src[sg] + 32 * nb, wdt, 64 * kb, Wcdin, 1024, seg_dst[sg] + 32 * nb, scr, F.lane); continue; } r -= I_CDI;
        if (r < I_CDO) { transpose_full(a.in[I_CDOUT], 1024, 1024, Wcdout, r, scr, F.lane); continue; } r -= I_CDO;
        if (r < I_MLP) { transpose_full(a.in[I_W1] + (size_t)1024 * 4096, 1024, 4096, W1 + (size_t)4096 * 1024, r, scr, F.lane); continue; } r -= I_MLP;
        transpose_full(a.in[I_W2] + (size_t)4096 * 1024, 4096, 1024, W2 + (size_t)1024 * 4096, r, scr, F.lane);
    }
    if (part == 2)
        for (int idx = wv * 64 + F.lane; idx < (PW - 3656) * 1024 / 8; idx += nwv * 64) *(u32x4*)(Wcdin + (size_t)3656 * 1024 + (size_t)idx * 8) = (u32x4){0u, 0u, 0u, 0u};
}

template <int WIN> __device__ __forceinline__ void pool_ld(u32x4 (&w)[WIN], const bf16_t* V, int row, int ch0) {
    const bf16_t* p = V + (size_t)row * 512 + ch0;
#pragma unroll
    for (int j = 0; j < WIN; ++j) w[j] = *(const u32x4*)(p - j * 512);
}
template <int WIN> __device__ __forceinline__ void pool_fin(const u32x4 (&w)[WIN], bf16_t* CAT, const float* scale, int row, int ch0) {
    const int t = row & 4095;
    float s[8];
#pragma unroll
    for (int q = 0; q < 8; ++q) s[q] = 0.f;
#pragma unroll
    for (int j = 0; j < WIN; ++j) { const bool in = (j <= t);
#pragma unroll
        for (int q = 0; q < 4; ++q) { s[2 * q] += in ? __uint_as_float(w[j][q] << 16) : 0.f; s[2 * q + 1] += in ? __uint_as_float(w[j][q] & 0xffff0000u) : 0.f; } }
    const float inv = 1.f / (float)((t + 1 < WIN) ? t + 1 : WIN); u32x4 o; const f32x4 sc0 = *(const f32x4*)(scale + ch0), sc1 = *(const f32x4*)(scale + ch0 + 4);
    float u0[8];
#pragma unroll
    for (int q = 0; q < 4; ++q) { u0[2 * q] = __uint_as_float(w[0][q] << 16); u0[2 * q + 1] = __uint_as_float(w[0][q] & 0xffff0000u); }
    o[0] = cvtpk((s[0] * inv - u0[0]) * sc0.x, (s[1] * inv - u0[1]) * sc0.y); o[1] = cvtpk((s[2] * inv - u0[2]) * sc0.z, (s[3] * inv - u0[3]) * sc0.w);
    o[2] = cvtpk((s[4] * inv - u0[4]) * sc1.x, (s[5] * inv - u0[5]) * sc1.y); o[3] = cvtpk((s[6] * inv - u0[6]) * sc1.z, (s[7] * inv - u0[7]) * sc1.w);
    *(u32x4*)(CAT + (size_t)row * 1024 + ch0) = o;
}
__device__ __forceinline__ void pool_post(const Frame& F, const Args& a, int wgi, int nwg) {
    const bf16_t* V = (const bf16_t*)(a.ws + WS_PA); bf16_t* CAT = (bf16_t*)(a.ws + WS_CAT); const float* scale = a.in[I_POOLS];
    for (int rq = wgi * NWAVES + F.wave; rq < MTOK / 4; rq += nwg * NWAVES) { const int row = rq * 4 + (F.lane >> 4), c8 = (F.lane & 15) * 8;
        u32x4 w2[2], w4[4], w8[8], w16[16];
        pool_ld<2>(w2, V, row, c8); pool_ld<4>(w4, V, row, 128 + c8); pool_ld<8>(w8, V, row, 256 + c8); pool_ld<16>(w16, V, row, 384 + c8);
        pool_fin<2>(w2, CAT, scale, row, c8); pool_fin<4>(w4, CAT, scale, row, 128 + c8); pool_fin<8>(w8, CAT, scale, row, 256 + c8); pool_fin<16>(w16, CAT, scale, row, 384 + c8); }
}

__device__ __forceinline__ void s5_recurrence(const Frame& F, const Args& a, int gwv) {
    if (gwv >= 128) return;
    const int b = gwv >> 5, g = gwv & 31, p = F.lane;
    const float* SST = (const float*)(a.ws + WS_SST); const float* APOW = (const float*)(a.ws + WS_APOW); bf16_t* UEXT = (bf16_t*)(a.ws + WS_UEXT);
    const float ar = APOW[(g * 64 + p) * 2], ai = APOW[(g * 64 + p) * 2 + 1];
    float hr = 0.f, hi = 0.f;
    const size_t row0 = (size_t)g * 512 + b * 128;
    for (int k0 = 0; k0 < 128; k0 += 16) { float sr[16], si[16];
#pragma unroll
        for (int j = 0; j < 16; ++j) { sr[j] = SST[(row0 + k0 + j) * 128 + p]; si[j] = SST[(row0 + k0 + j) * 128 + 64 + p]; }
#pragma unroll
        for (int j = 0; j < 16; ++j) { bf16_t* o = UEXT + (row0 + k0 + j) * 640 + 512 + p;
            const unsigned w = cvtpk(hr, hi); o[0] = (bf16_t)(w & 0xffffu); o[64] = (bf16_t)(w >> 16);
            const float nr = ar * hr - ai * hi + sr[j], ni = ar * hi + ai * hr + si[j]; hr = nr; hi = ni; } }
}

__device__ __forceinline__ unsigned sortable(float f) { const unsigned u = __float_as_uint(f); return (u & 0x80000000u) ? ~u : (u | 0x80000000u); }
__device__ __forceinline__ void idx_unit(const Frame& F, const Args& a, int b, int qt) {
    int tid = F.tid; asm volatile("" : "+v"(tid)); const int lane = tid & 63, w = F.wave, qq = lane & 15, g4 = lane >> 4;
    const int q0 = qt * 16, ntile = 4 * ((q0 >> 6) + 1);
    const bf16_t* P = (const bf16_t*)(a.ws + WS_PROJ) + (size_t)b * SEQ * PW;
    const float* WI = (const float*)(a.ws + WS_WIF) + ((size_t)b * SEQ + q0 + qq) * 8;
    LAS bf16_t* qil = (LAS bf16_t*)(F.lds);
#pragma unroll
    for (int e = 0; e < 2; ++e) { const int idx = tid + 512 * e, row = idx >> 6, seg = idx & 63;
        *(LAS u32x4*)(qil + row * 520 + seg * 8) = *(const u32x4*)(P + (size_t)(q0 + row) * PW + PC_QI + seg * 8); }
    float wh[8];
    { const f32x4 w0 = *(const f32x4*)WI, w1 = *(const f32x4*)(WI + 4); wh[0] = w0.x; wh[1] = w0.y; wh[2] = w0.z; wh[3] = w0.w; wh[4] = w1.x; wh[5] = w1.y; wh[6] = w1.z; wh[7] = w1.w; }
    __syncthreads();
    const int nj = (ntile - w + 7) >> 3;
    unsigned sc[32][4];
    constexpr int TG = 2;
#pragma unroll
    for (int jj = 0; jj < 32 / TG; ++jj) {
        if (TG * jj < nj) {
            bf16x8 kf[TG][2];
#pragma unroll
            for (int u = 0; u < TG; ++u) { int kt = 8 * (TG * jj + u) + w; kt = kt < ntile ? kt : ntile - 1; const bf16_t* kp = P + (size_t)(16 * kt + qq) * PW + PC_KI + 8 * g4;
                kf[u][0] = *(const bf16x8*)kp; kf[u][1] = *(const bf16x8*)(kp + 32); }
            f32x4 s4[TG];
#pragma unroll
            for (int u = 0; u < TG; ++u) s4[u] = (f32x4){0.f, 0.f, 0.f, 0.f};
#pragma unroll
            for (int h = 0; h < 8; ++h) { int qoff = qq * 520 + 8 * g4; asm volatile("" : "+v"(qoff));
                const bf16x8 qa = *(const LAS bf16x8*)(qil + qoff + h * 64), qb = *(const LAS bf16x8*)(qil + qoff + h * 64 + 32);
#pragma unroll
                for (int u = 0; u < TG; ++u) { f32x4 acc = __builtin_amdgcn_mfma_f32_16x16x32_bf16(kf[u][0], qa, (f32x4){0.f, 0.f, 0.f, 0.f}, 0, 0, 0);
                    acc = __builtin_amdgcn_mfma_f32_16x16x32_bf16(kf[u][1], qb, acc, 0, 0, 0);
#pragma unroll
                    for (int i = 0; i < 4; ++i) s4[u][i] = __builtin_fmaf(fmaxf(acc[i], 0.f), wh[h], s4[u][i]); }
                __builtin_amdgcn_sched_barrier(0); }
#pragma unroll
            for (int u = 0; u < TG; ++u) { const bool ok = (8 * (TG * jj + u) + w) < ntile;
#pragma unroll
                for (int i = 0; i < 4; ++i) sc[TG * jj + u][i] = ok ? sortable(s4[u][i]) : 0u; }
        } else {
#pragma unroll
            for (int u = 0; u < TG; ++u)
#pragma unroll
                for (int i = 0; i < 4; ++i) sc[TG * jj + u][i] = 0u;
        }
    }
    __syncthreads();
    const int nc = ntile >> 2;
    unsigned long long* MASK64 = (unsigned long long*)(a.ws + WS_MASK) + ((size_t)b * SEQ + q0) * 64;
#pragma unroll 1
    for (int hh = 0; hh < 2; ++hh) {
        if ((qq >> 3) == hh) { const int q3 = qq & 7;
            LAS unsigned char* wb = F.lds + q3 * 16384 + (((4 * w + g4) ^ q3) << 4);
#pragma unroll
            for (int j = 0; j < 32; ++j) *(LAS u32x4*)(wb + 512 * j) = (u32x4){sc[j][0], sc[j][1], sc[j][2], sc[j][3]}; }
        __syncthreads();
        unsigned kq[64]; const LAS unsigned char* rb = F.lds + w * 16384 + ((((lane >> 2) ^ w)) << 4) + ((lane & 3) << 2);
#pragma unroll
        for (int cg = 0; cg < 8; ++cg) {
            if (8 * cg < nc) {
#pragma unroll
                for (int c8 = 0; c8 < 8; ++c8) { const int c = 8 * cg + c8; kq[c] = *(const LAS unsigned*)(rb + 256 * c); }
            } else {
#pragma unroll
                for (int c8 = 0; c8 < 8; ++c8) kq[8 * cg + c8] = 0u;
            } }
        __syncthreads();
#define IDX_CNT4(dst, candv, k0, k1, k2, k3) do { unsigned long long m0_, m1_, m2_, m3_; unsigned t0_, t1_, t2_, t3_; \
            asm volatile("v_cmp_le_u32_e64 %1, %9, %10\n\tv_cmp_le_u32_e64 %2, %9, %11\n\tv_cmp_le_u32_e64 %3, %9, %12\n\tv_cmp_le_u32_e64 %4, %9, %13\n\t" \
                         "s_bcnt1_i32_b64 %5, %1\n\ts_bcnt1_i32_b64 %6, %2\n\ts_bcnt1_i32_b64 %7, %3\n\ts_bcnt1_i32_b64 %8, %4\n\t" \
                         "s_add_u32 %0, %0, %5\n\ts_add_u32 %0, %0, %6\n\ts_add_u32 %0, %0, %7\n\ts_add_u32 %0, %0, %8" \
                         : "+s"(dst), "=&s"(m0_), "=&s"(m1_), "=&s"(m2_), "=&s"(m3_), "=&s"(t0_), "=&s"(t1_), "=&s"(t2_), "=&s"(t3_) \
                         : "s"(candv), "v"(k0), "v"(k1), "v"(k2), "v"(k3) : "scc"); } while (0)
#define IDX_COUNT(dst, candv) do { dst = 0u; _Pragma("unroll") for (int cg = 0; cg < 8; ++cg) if (8 * cg < nc) { \
            IDX_CNT4(dst, candv, kq[8 * cg], kq[8 * cg + 1], kq[8 * cg + 2], kq[8 * cg + 3]); IDX_CNT4(dst, candv, kq[8 * cg + 4], kq[8 * cg + 5], kq[8 * cg + 6], kq[8 * cg + 7]); } } while (0)
        unsigned T = 1u, need = 0u; bool tie = false;
        if (nc * 64 > 256) {
            unsigned kmax = 0u, km1 = 0xffffffffu;
#pragma unroll
            for (int c = 0; c < 64; ++c) { kmax = kq[c] > kmax ? kq[c] : kmax; km1 = (kq[c] - 1u < km1) ? kq[c] - 1u : km1; }
#pragma unroll
            for (int o = 1; o < 64; o <<= 1) { const unsigned t = (unsigned)__shfl_xor((int)kmax, o), t2 = (unsigned)__shfl_xor((int)km1, o); kmax = t > kmax ? t : kmax; km1 = t2 < km1 ? t2 : km1; }
            kmax = (unsigned)__builtin_amdgcn_readfirstlane((int)kmax); km1 = (unsigned)__builtin_amdgcn_readfirstlane((int)km1);
            unsigned lo = km1 + 1u, hi = kmax + 1u, clo = (unsigned)(nc * 64), chi = 0u; bool triedz = false;
            for (int it = 0; it < 72; ++it) {
                if (clo == 256u || hi - lo <= 1u) break;
                unsigned cand;
                if (lo < 0x80000000u && hi > 0x80000000u) cand = 0x80000000u;
                else if (lo == 0x80000000u && !triedz) { cand = 0x80000001u; triedz = true; }
                else { const unsigned ul = (lo & 0x80000000u) ? (lo ^ 0x80000000u) : ~lo, uh = (hi & 0x80000000u) ? (hi ^ 0x80000000u) : ~hi;
                    cand = sortable(0.5f * (__uint_as_float(ul) + __uint_as_float(uh)));
                    if (it >= 26 || cand <= lo || cand >= hi) cand = lo + ((hi - lo) >> 1); }
                cand = cand > lo ? cand : lo + 1u; cand = cand < hi ? cand : hi - 1u;
                unsigned cnt; IDX_COUNT(cnt, cand);
                if (cnt >= 256u) { lo = cand; clo = cnt; } else { hi = cand; chi = cnt; }
            }
            T = lo; tie = clo > 256u; need = 256u - chi;
        }
        unsigned long long myword = 0ull; int lane_o = lane; asm volatile("" : "+v"(lane_o));
        if (!tie) {
#pragma unroll
            for (int cg = 0; cg < 8; ++cg) if (8 * cg < nc) {
#pragma unroll
                for (int c8 = 0; c8 < 8; ++c8) { const int c = 8 * cg + c8; const unsigned long long wsel = __builtin_amdgcn_ballot_w64(kq[c] >= T); if (lane_o == c) myword = wsel; } }
        } else {
#pragma unroll 1
            for (int c = 0; c < nc; ++c) { unsigned k_ = 0u;
#pragma unroll
                for (int cc = 0; cc < 64; ++cc) k_ = (cc == c) ? kq[cc] : k_;
                unsigned long long wsel = __builtin_amdgcn_ballot_w64(k_ > T), eq = __builtin_amdgcn_ballot_w64(k_ == T);
                const unsigned t = (unsigned)__builtin_popcountll(eq);
                if (t <= need) { wsel |= eq; need -= t; }
                else { while (need) { const unsigned long long lowbit = eq & (0ull - eq); wsel |= lowbit; eq ^= lowbit; --need; } }
                if (lane_o == c) myword = wsel; }
        }
        MASK64[(size_t)(8 * hh + w) * 64 + lane] = myword;
#undef IDX_COUNT
#undef IDX_CNT4
    }
}

__global__ void __launch_bounds__(NWAVES * 64, 2) mk_fwd(Args args_unused) {
    extern __shared__ __attribute__((aligned(16))) unsigned char lds[];
    Frame F;
    F.lds = (LAS unsigned char*)lds;
    F.tid = threadIdx.x; F.lane = F.tid & 63; F.wave = __builtin_amdgcn_readfirstlane(F.tid >> 6);
    F.G = gridDim.x; { const int bx = blockIdx.x; F.vcu = (F.G % 8 == 0) ? (bx % 8) * (F.G / 8) + bx / 8 : bx; }
    typedef const Args __attribute__((address_space(4))) * kargp_t;
    const kargp_t ap = (kargp_t)__builtin_amdgcn_kernarg_segment_ptr();
#define PHASE_ARGS() kargp_t ap_ = ap; asm volatile("" : "+s"(ap_)); Args a; __builtin_memcpy(&a, (const void __attribute__((address_space(4)))*)ap_, sizeof(Args)); unsigned char* const ws = a.ws; (void)ws
    volatile LAS unsigned* MISC = (volatile LAS unsigned*)(F.lds + MISC_OFF);
    for (int u = F.tid; u < (LDS_BYTES - LDSCTL_OFF) / 4; u += NWAVES * 64) ((LAS unsigned*)(F.lds + LDSCTL_OFF))[u] = 0u;
    __syncthreads();
    XcdBarrier bar; bar.bar = nullptr; bar.x = 0; bar.st = nullptr;
#if !MK_PER_PHASE
    { PHASE_ARGS(); bar = xcd_barrier_post((unsigned*)(ws + WS_CTL) + CW_BAR, MISC + 8); }
#define GRID_BAR() xcd_barrier(bar)
#else
#define GRID_BAR() do {} while (0)
#endif
    int lo, hi; { PHASE_ARGS(); lo = a.ph_lo; hi = a.ph_hi; }
#ifndef PH_MASK
#define PH_MASK 0xFFFFFu
#endif
#define IN(k) ((((PH_MASK) >> (k)) & 1u) && lo <= (k) && (k) < hi)
#ifndef PROBE_DUP
#define PROBE_DUP 0u
#endif
#define NREP(k) ((((PROBE_DUP) >> (k)) & 1u) ? 2 : 1)
#define SEAM(k) do { if (IN(k) && IN((k) + 1)) GRID_BAR(); } while (0)
#define PHASE_1(k) if (IN(k))
#define PHASE_2(k) for (int rep_ = 0; rep_ < 2; ++rep_) if (IN(k))
#define PHASE_SEL(k, n) PHASE_##n(k)
#define PHASE(k) if (IN(k)) for (int rep_ = 0; rep_ < NREP(k); ++rep_)
    const int bx = (int)blockIdx.x;
    using namespace pg8;
#define WSP(T, off) ((T*)(ws + (off)))
#define MODF_GATE(is) (WSP(const float, WS_MODF) + (is) * 4 * 3072 + 2048)

    PHASE(0) { PHASE_ARGS(); phase_p0a(F, a); } SEAM(0);
    PHASE(1) { PHASE_ARGS(); phase_p0b(F, a); } SEAM(1);
    PHASE(2) { PHASE_ARGS(); Gemm g{WSP(bf16_t, WS_H), WSP(const bf16_t, WS_W_ABIN), 1024, 1024, 1024}; Sched<SM_STD> S; S.init(64, 4, F.G, bx);
        EpiInAB E{WSP(bf16_t, WS_UA), WSP(bf16_t, WS_UEXT)}; gemm_phase<EpiInAB, Sched<SM_STD>, true>(F.lds + RING_OFF, g, S, E); } SEAM(2);
    PHASE(3) { PHASE_ARGS();
        LAS float* scr = (LAS float*)(F.lds + RING_OFF + F.wave * 8704);
        if (F.G >= 256) {
            if (bx < 64) { Gemm g{WSP(const bf16_t, WS_UEXT), WSP(const bf16_t, WS_BTS), 640, 512, 512}; Sched<SM_S5S> S; S.init(64, 1, 64, bx);
                EpiStateF32 E{WSP(float, WS_SST)}; gemm_phase<EpiStateF32, Sched<SM_S5S>, true>(F.lds + RING_OFF, g, S, E);
                if (F.wave < 2) { __builtin_amdgcn_fence(__ATOMIC_ACQUIRE, "agent"); s5_recurrence(F, a, (2 * (bx & 1) + F.wave) * 32 + (bx >> 1)); } }
            else if (bx < 192) { Gemm g{WSP(const bf16_t, WS_UA), WSP(const bf16_t, WS_W_POOL), 512, 256, 256}; Sched<SM_POOL> S; S.init(64, 2, 128, bx - 64);
                EpiBf16Plain E{WSP(bf16_t, WS_PA), 512}; gemm_phase<EpiBf16Plain, Sched<SM_POOL>, true>(F.lds + RING_OFF, g, S, E); }
            else convert_late(F, a, 0, (bx - 192) * 8 + F.wave, (F.G - 192) * 8, scr);
        } else {
        }
    } SEAM(3);
    PHASE(4) { PHASE_ARGS();
        Gemm g{WSP(const bf16_t, WS_UEXT), WSP(const bf16_t, WS_BTY), 640, 640, 640}; Sched<SM_S5Y> S; S.init(64, 2, F.G, bx);
        EpiYGelu E{WSP(bf16_t, WS_YB)}; gemm_phase<EpiYGelu, Sched<SM_S5Y>, true>(F.lds + RING_OFF, g, S, E);
        if (bx >= 128) { LAS float* scr = (LAS float*)(F.lds + RING_OFF + F.wave * 8704); pool_post(F, a, bx - 128, F.G - 128); convert_late(F, a, 1, (bx - 128) * 8 + F.wave, (F.G - 128) * 8, scr); }
    } SEAM(4);
    PHASE(6) { PHASE_ARGS(); Gemm g{WSP(const bf16_t, WS_YB), WSP(const bf16_t, WS_W_GLU), 512, 512, 512}; Sched<SM_STD> S; S.init(64, 2, F.G, bx);
        EpiGlu E{WSP(bf16_t, WS_CAT), WSP(const bf16_t, WS_YB), a.in[I_GLUB]}; gemm_phase<EpiGlu, Sched<SM_STD>, true>(F.lds + RING_OFF, g, S, E);
        if (bx >= 128) { LAS float* scr = (LAS float*)(F.lds + RING_OFF + F.wave * 8704); convert_late(F, a, 2, (bx - 128) * 8 + F.wave, (F.G - 128) * 8, scr); } } SEAM(6);
    PHASE(7) { PHASE_ARGS(); Gemm g{WSP(bf16_t, WS_CAT), WSP(const bf16_t, WS_W_ABOUT), 1024, 1024, 1024}; Sched<SM_STD> S; S.init(64, 4, F.G, bx);
        EpiResidNorm<true> E{a.in[I_X], nullptr, (bf16_t*)ws, MODF_GATE(0), WSP(const float, WS_GS), WSP(bf16_t, WS_H), WSP(float, WS_SSQ)}; gemm_phase<EpiResidNorm<true>, Sched<SM_STD>, true>(F.lds + RING_OFF, g, S, E);
        { const int wv = F.wave * F.G + F.vcu, nwv = F.G * NWAVES; const float* MF = WSP(const float, WS_MODF); float* SW = WSP(float, WS_SW);
          LAS bf16_t* shl = (LAS bf16_t*)(F.lds + RING_OFF);
          stage_shift3(F, MF, shl);
          for (int blk = wv; blk < 256 + 240 + 256; blk += nwv) {
              if (blk < 256) sw_block(F, WSP(const bf16_t, WS_W1), 4096, blk, shl, SW);
              else if (blk < 496) sw_block(F, WSP(const bf16_t, WS_W_CDIN), PW, blk - 256, shl + 4096, SW + SW_OFF1);
              else sw_block(F, WSP(const bf16_t, WS_W1) + (size_t)4096 * 1024, 4096, blk - 496, shl + 8192, SW + SW_OFF2); } } } SEAM(7);
    PHASE(9) { PHASE_ARGS(); Gemm g{WSP(bf16_t, WS_H), WSP(const bf16_t, WS_W1), 1024, 1024, 1024}; Sched<SM_STD> S; S.init(64, 16, F.G, bx);
        EpiRelu2N E{WSP(bf16_t, WS_BIG), WSP(const float, WS_SSQ), WSP(const float, WS_SW), -1, {}};
        { Unit u0; if (S.next(0, u0)) { E.pm0 = u0.pm; load_rstd(E.rs0, E.SSQ, u0.pm * 256 + (F.wave >> 2) * 64 + (F.lane & 15), F.lane >> 4); } }
        gemm_phase<EpiRelu2N, Sched<SM_STD>, true>(F.lds + RING_OFF, g, S, E); } SEAM(9);
    PHASE(10) { PHASE_ARGS(); Gemm g{WSP(bf16_t, WS_BIG), WSP(const bf16_t, WS_W2), 4096, 4096, 4096}; Sched<SM_STD> S; S.init(64, 4, F.G, bx);
        EpiResidNorm<false> E{nullptr, (const bf16_t*)ws, (bf16_t*)ws, MODF_GATE(1), WSP(const float, WS_GS) + 4096, WSP(bf16_t, WS_H), WSP(float, WS_SSQ)}; gemm_phase<EpiResidNorm<false>, Sched<SM_STD>, true>(F.lds + RING_OFF, g, S, E); } SEAM(10);
    PHASE(12) { PHASE_ARGS(); Gemm g{WSP(bf16_t, WS_H), WSP(const bf16_t, WS_W_CDIN), 1024, 1024, 1024}; Sched<SM_STD> S; S.init(64, 15, F.G, bx);
        EpiInCDN E{WSP(bf16_t, WS_PROJ), WSP(float, WS_WIF), WSP(const float, WS_SSQ), WSP(const float, WS_SW) + SW_OFF1, -1, {}};
        { Unit u0; if (S.next(0, u0)) { E.pm0 = u0.pm; load_rstd(E.rs0, E.SSQ, u0.pm * 256 + (F.wave >> 2) * 64 + (F.lane & 15), F.lane >> 4); } }
        gemm_phase<EpiInCDN, Sched<SM_STD>, true>(F.lds + RING_OFF, g, S, E); } SEAM(12);
    PHASE(13) { PHASE_ARGS();
        for (int v = F.vcu; v < 256; v += F.G) { const int b = v >> 6, s = v & 63;
            idx_unit(F, a, b, s); idx_unit(F, a, b, 127 - s); idx_unit(F, a, b, 128 + s); idx_unit(F, a, b, 255 - s); }
    } SEAM(13);
    PHASE(14) { PHASE_ARGS();
        const attn_body::bf16* PB = WSP(const attn_body::bf16, WS_PROJ); attn_body::bf16* PO = WSP(attn_body::bf16, WS_PROJ);
        const unsigned long long* MASK = WSP(const unsigned long long, WS_MASK);
        for (int v = F.vcu; v < 256; v += F.G) { const int bh = v >> 3, s = v & 7, b = bh >> 3, h = bh & 7;
#if (PROBE_DUP >> 20) & 1
            attn_body::dsa_unit<8>(b, h, 15 - s, PB + PC_QC, PB + PC_KC, PB + PC_VC, PO + PC_QI, MASK, (char*)lds + RING_OFF);
            attn_body::dsa_unit<8>(b, h, s, PB + PC_QC, PB + PC_KC, PB + PC_VC, PO + PC_QI, MASK, (char*)lds + RING_OFF);
#endif
#if (PROBE_DUP >> 21) & 1
            attn_body::sb_unit<SB_EARLY != 0>(b, h, 15 - s, PB + PC_QD, PB + PC_KD, PB + PC_VD, PO + PC_QI, (char*)lds + RING_OFF);
            attn_body::sb_unit<SB_EARLY != 0>(b, h, s, PB + PC_QD, PB + PC_KD, PB + PC_VD, PO + PC_QI, (char*)lds + RING_OFF);
#endif
#ifndef NO_DSA
            attn_body::dsa_unit<8>(b, h, 15 - s, PB + PC_QC, PB + PC_KC, PB + PC_VC, PO + PC_QC, MASK, (char*)lds + RING_OFF);
#endif
#ifndef NO_SB
            attn_body::sb_unit<SB_EARLY != 0>(b, h, 15 - s, PB + PC_QD, PB + PC_KD, PB + PC_VD, PO + PC_QD, (char*)lds + RING_OFF);
#endif
#ifndef NO_DSA
            attn_body::dsa_unit<8>(b, h, s, PB + PC_QC, PB + PC_KC, PB + PC_VC, PO + PC_QC, MASK, (char*)lds + RING_OFF);
#endif
#ifndef NO_SB
            attn_body::sb_unit<SB_EARLY != 0>(b, h, s, PB + PC_QD, PB + PC_KD, PB + PC_VD, PO + PC_QD, (char*)lds + RING_OFF);
#endif
        }
    } SEAM(14);
    PHASE(15) { PHASE_ARGS(); Gemm g{WSP(bf16_t, WS_PROJ), WSP(const bf16_t, WS_W_CDOUT), PW, 1024, 1024}; Sched<SM_STD> S; S.init(64, 4, F.G, bx);
        EpiResidNorm<false> E{nullptr, (const bf16_t*)ws, (bf16_t*)ws, MODF_GATE(2), WSP(const float, WS_GS) + 8192, WSP(bf16_t, WS_H), WSP(float, WS_SSQ)}; gemm_phase<EpiResidNorm<false>, Sched<SM_STD>, true>(F.lds + RING_OFF, g, S, E); } SEAM(15);
    PHASE(17) { PHASE_ARGS(); Gemm g{WSP(bf16_t, WS_H), WSP(const bf16_t, WS_W1) + (size_t)4096 * 1024, 1024, 1024, 1024}; Sched<SM_STD> S; S.init(64, 16, F.G, bx);
        EpiRelu2N E{WSP(bf16_t, WS_BIG), WSP(const float, WS_SSQ), WSP(const float, WS_SW) + SW_OFF2, -1, {}};
        { Unit u0; if (S.next(0, u0)) { E.pm0 = u0.pm; load_rstd(E.rs0, E.SSQ, u0.pm * 256 + (F.wave >> 2) * 64 + (F.lane & 15), F.lane >> 4); } }
        gemm_phase<EpiRelu2N, Sched<SM_STD>, true>(F.lds + RING_OFF, g, S, E); } SEAM(17);
    PHASE(18) { PHASE_ARGS(); Gemm g{WSP(bf16_t, WS_BIG), WSP(const bf16_t, WS_W2) + (size_t)1024 * 4096, 4096, 4096, 4096}; Sched<SM_STD> S; S.init(64, 4, F.G, bx);
        EpiResidNorm<false, false> E{nullptr, (const bf16_t*)ws, nullptr, MODF_GATE(3), WSP(const float, WS_GS) + 12288, WSP(bf16_t, WS_H), WSP(float, WS_SSQ)};
        gemm_phase<EpiResidNorm<false, false>, Sched<SM_STD>, true>(F.lds + RING_OFF, g, S, E); } SEAM(18);
    PHASE(19) { PHASE_ARGS();
        const bf16_t* Hf = WSP(const bf16_t, WS_H); const float* SSQ = WSP(const float, WS_SSQ); float* outp = a.out;
        for (int row0 = (F.vcu * NWAVES + F.wave) * 4; row0 < MTOK; row0 += F.G * NWAVES * 4) {
            u32x4 hw[4][2]; f32x4 p[4][4];
#pragma unroll
            for (int q = 0; q < 4; ++q) { const f32x4* sp = (const f32x4*)(SSQ + (size_t)(row0 + q) * 16);
#pragma unroll
                for (int e = 0; e < 4; ++e) p[q][e] = sp[e];
#pragma unroll
                for (int j = 0; j < 2; ++j) hw[q][j] = *(const u32x4*)(Hf + (size_t)(row0 + q) * 1024 + 512 * j + 8 * F.lane); }
#pragma unroll
            for (int q = 0; q < 4; ++q) {
                const float ssum = ((p[q][0].x + p[q][0].y) + (p[q][0].z + p[q][0].w)) + ((p[q][1].x + p[q][1].y) + (p[q][1].z + p[q][1].w)) + ((p[q][2].x + p[q][2].y) + (p[q][2].z + p[q][2].w)) + ((p[q][3].x + p[q][3].y) + (p[q][3].z + p[q][3].w));
                const float rstd = 1.f / sqrtf(ssum * (1.f / 1024.f) + EPS);
#pragma unroll
                for (int j = 0; j < 2; ++j) { const size_t o = (size_t)(row0 + q) * 1024 + 512 * j + 8 * F.lane; f32x4 x0, x1; unpack8(hw[q][j], x0, x1);
                    *(f32x4*)(outp + o) = x0 * rstd; *(f32x4*)(outp + o + 4) = x1 * rstd; } } }
    }
#undef IN
#undef SEAM
}

extern "C" void kernel_launch(void* const* d_in, const int* in_sizes, int n_in, void* d_out, int out_size, void* d_ws, size_t ws_size, hipStream_t stream) {
    static int grid = 0;
    if (grid == 0) {
        if (n_in != N_IN || out_size != MTOK * DM || ws_size < WS_END) { fprintf(stderr, "kernel_launch: unexpected shapes (n_in %d out %d ws %zu)\n", n_in, out_size, ws_size); grid = -1; return; }
        int dev = 0, cus = 0;
        if (hipGetDevice(&dev) != hipSuccess || hipDeviceGetAttribute(&cus, hipDeviceAttributeMultiprocessorCount, dev) != hipSuccess) { grid = -1; return; }
        if (hipFuncSetAttribute((const void*)mk_fwd, hipFuncAttributeMaxDynamicSharedMemorySize, LDS_BYTES) != hipSuccess) { fprintf(stderr, "kernel_launch: hipFuncSetAttribute failed\n"); grid = -1; return; }
        int per_cu = 0;
        if (hipOccupancyMaxActiveBlocksPerMultiprocessor(&per_cu, (const void*)mk_fwd, NWAVES * 64, LDS_BYTES) != hipSuccess || per_cu < 1) fprintf(stderr, "kernel_launch: occupancy query reports %d\n", per_cu);
        (void)hipGetLastError();
        grid = cus;
        if (grid < 256) { fprintf(stderr, "kernel_launch: this build assigns fixed roles to 256 workgroups (MI355X: 256 CUs); found %d CUs, nothing launched\n", cus); grid = -1; return; }
        grid = 256;
    }
    if (grid < 0) return;
    Args a{};
    for (int i = 0; i < N_IN; ++i) a.in[i] = (const float*)d_in[i];
    a.out = (float*)d_out; a.ws = (unsigned char*)d_ws;
#if MK_PER_PHASE
    for (int p = 0; p < NPHASE; ++p) { a.ph_lo = p; a.ph_hi = p + 1; hipLaunchKernelGGL(mk_fwd, dim3(grid), dim3(NWAVES * 64), LDS_BYTES, stream, a); }
#else
    if (hipMemsetAsync((char*)d_ws + WS_CTL, 0, CTL_ZERO_BYTES, stream) != hipSuccess) { fprintf(stderr, "kernel_launch: memset failed\n"); return; }
    a.ph_lo = 0; a.ph_hi = NPHASE;
    hipLaunchKernelGGL(mk_fwd, dim3(grid), dim3(NWAVES * 64), LDS_BYTES, stream, a);
#endif
    const hipError_t le = hipPeekAtLastError();
    if (le != hipSuccess) fprintf(stderr, "kernel_launch: launch failed: %s\n", hipGetErrorName(le));
}
```
